# Optimizing an MI355X kernel written in HIP

```python
import math
import jax
import jax.numpy as jnp
from jax import lax
import numpy as np


D_MODEL = 1024
BATCH = 8
SEQ = 4096
DEPTH = 2

HEAD_DIM = 64
ROPE_THETA = 10000.0
BLOCK = 128
LN_EPS = 1e-5

POOL_WINDOWS = (2, 4, 8, 16)
POOL_GROUP = 64
POOL_WIDTH = len(POOL_WINDOWS) * POOL_GROUP
SWA_WINDOW = 128
SWA_Q_HEADS = 12
SWA_KV_HEADS = 4
SWA_Q_DIM = SWA_Q_HEADS * HEAD_DIM
SWA_KV_DIM = SWA_KV_HEADS * HEAD_DIM
DIL_PAIRS = ((128, 1), (512, 4), (2048, 16))
DIL_Q_HEADS = 8
DIL_KV_HEADS = 2
DIL_Q_DIM = DIL_Q_HEADS * HEAD_DIM
DIL_KV_DIM = DIL_KV_HEADS * HEAD_DIM
DIL_GROUP_IN = DIL_Q_DIM + 2 * DIL_KV_DIM
CONV_WIDTH = 512
CONV_K = 3
D_FF = 2816
N_EXPERTS = 8
TOP_K = 2
D_FF_EXPERT = 3584
MOE_BLOCK = 256

ALPHA = (2 * DEPTH) ** 0.25
BETA = (8 * DEPTH) ** -0.25
N_EVEN = (DEPTH + 1) // 2
N_ODD = DEPTH // 2
EVEN_IN = POOL_WIDTH + SWA_Q_DIM + 2 * SWA_KV_DIM
EVEN_MIX = POOL_WIDTH + SWA_Q_DIM
C_IN = len(DIL_PAIRS) * DIL_GROUP_IN
ODD_IN = C_IN + 3 * CONV_WIDTH
ODD_MIX = DIL_Q_DIM + CONV_WIDTH

kernel_name = 'hybrid_pool_swa_dilated_conv_moe'


def layer_norm(x, w, b):
    xf = x.astype(jnp.float32)
    mu = xf.mean(-1, keepdims=True)
    var = jnp.square(xf - mu).mean(-1, keepdims=True)
    return ((xf - mu) * lax.rsqrt(var + LN_EPS) * w + b).astype(x.dtype)


def rope(x, positions):
    half = x.shape[-1] // 2
    inv = ROPE_THETA ** (-jnp.arange(half, dtype=jnp.float32) / half)
    ang = positions.astype(jnp.float32)[..., None] * inv
    cos = jnp.cos(ang)[:, :, None, :]
    sin = jnp.sin(ang)[:, :, None, :]
    xf = x.astype(jnp.float32)
    x1, x2 = xf[..., :half], xf[..., half:]
    return jnp.concatenate([x1 * cos - x2 * sin, x2 * cos + x1 * sin], -1).astype(x.dtype)


def banded_attention(q, k, v, max_dist, sinks=None):
    n, L, H, dh = q.shape
    kvh = k.shape[2]
    g = H // kvh
    nblk = -(-L // BLOCK)
    Lp = nblk * BLOCK
    pad = ((0, 0), (0, Lp - L), (0, 0), (0, 0))
    q, k, v = jnp.pad(q, pad), jnp.pad(k, pad), jnp.pad(v, pad)
    qb = q.reshape(n, nblk, BLOCK, kvh, g, dh).transpose(1, 0, 2, 3, 4, 5)

    def windows(t):
        tb = t.reshape(n, nblk, BLOCK, kvh, dh)
        prev = jnp.concatenate([jnp.zeros_like(tb[:, :1]), tb[:, :-1]], axis=1)
        return jnp.concatenate([prev, tb], axis=2).transpose(1, 0, 2, 3, 4)

    kw, vw = windows(k), windows(v)
    qi = jnp.arange(BLOCK)[:, None]
    sj = jnp.arange(2 * BLOCK)[None, :]
    dist = BLOCK + qi - sj
    band = (dist >= 0) & (dist <= max_dist)
    scale = 1.0 / math.sqrt(dh)

    def block(args):
        qblk, kblk, vblk, bi = args
        s = jnp.einsum('nqkgd,nskd->nkgqs', qblk, kblk, preferred_element_type=jnp.float32) * scale
        valid = band & ((bi * BLOCK + sj - BLOCK) >= 0)
        s = jnp.where(valid, s, -jnp.inf)
        m = s.max(-1, keepdims=True)
        if sinks is not None:
            sk = sinks.astype(jnp.float32).reshape(kvh, g, 1, 1)
            m = jnp.maximum(m, sk)
        p = jnp.exp(s - m)
        den = p.sum(-1, keepdims=True)
        if sinks is not None:
            den = den + jnp.exp(sk - m)
        o = jnp.einsum('nkgqs,nskd->nqkgd', (p / den).astype(vblk.dtype), vblk)
        return o, (m + jnp.log(den))[..., 0]

    o, lse = lax.map(block, (qb, kw, vw, jnp.arange(nblk)))
    o = o.transpose(1, 0, 2, 3, 4, 5).reshape(n, Lp, H, dh)[:, :L]
    lse = lse.transpose(1, 0, 4, 2, 3).reshape(n, Lp, H)[:, :L]
    return o, lse


def multiscale_pool(u, w_group, scale):
    b, s, _ = u.shape
    uf = u.astype(jnp.float32)
    csum = jnp.cumsum(uf, axis=1)
    count = jnp.arange(1, s + 1, dtype=jnp.float32)[None, :, None]
    diffs = []
    for gi, w in enumerate(POOL_WINDOWS):
        sl = slice(gi * POOL_GROUP, (gi + 1) * POOL_GROUP)
        cg = csum[..., sl]
        lagged = jnp.pad(cg, ((0, 0), (w, 0), (0, 0)))[:, :s]
        diffs.append((cg - lagged) / jnp.minimum(count, w) - uf[..., sl])
    d = jnp.stack(diffs, axis=2).astype(u.dtype)
    y = jnp.einsum('bsgc,gcd->bsgd', d, w_group).reshape(b, s, POOL_WIDTH)
    return y * scale


def even_mixer(x, positions, w_in, pool_w, pool_scale, sinks, w_out):
    b, s, _ = x.shape
    h = x @ w_in
    u, q, k, v = jnp.split(h, [POOL_WIDTH, POOL_WIDTH + SWA_Q_DIM, POOL_WIDTH + SWA_Q_DIM + SWA_KV_DIM], axis=-1)
    a_out = multiscale_pool(u, pool_w, pool_scale)
    q = rope(q.reshape(b, s, SWA_Q_HEADS, HEAD_DIM), positions)
    k = rope(k.reshape(b, s, SWA_KV_HEADS, HEAD_DIM), positions)
    v = v.reshape(b, s, SWA_KV_HEADS, HEAD_DIM)
    b_out, _ = banded_attention(q, k, v, SWA_WINDOW - 1, sinks)
    return jnp.concatenate([a_out, b_out.reshape(b, s, SWA_Q_DIM)], -1) @ w_out


def dilated_attention(q, k, v, window, dil):
    b, s = q.shape[:2]

    def to_sub(t):
        return t.reshape(b, s // dil, dil, *t.shape[2:]).swapaxes(1, 2).reshape(b * dil, s // dil, *t.shape[2:])

    def from_sub(t):
        return t.reshape(b, dil, s // dil, *t.shape[2:]).swapaxes(1, 2).reshape(b, s, *t.shape[2:])

    o, lse = banded_attention(to_sub(q), to_sub(k), to_sub(v), window // dil)
    return from_sub(o), from_sub(lse)


def short_conv(h, gate_b, gate_c, conv_w):
    z = gate_c * h
    y = lax.conv_general_dilated(z, conv_w[:, None, :], window_strides=(1,), padding=[(CONV_K - 1, 0)],
                                 dimension_numbers=('NWC', 'WIO', 'NWC'), feature_group_count=CONV_WIDTH)
    return gate_b * y


def odd_mixer(x, positions, w_in, conv_w, w_out):
    b, s, _ = x.shape
    h = x @ w_in
    outs, lses = [], []
    for gi, (window, dil) in enumerate(DIL_PAIRS):
        hg = h[..., gi * DIL_GROUP_IN:(gi + 1) * DIL_GROUP_IN]
        q, k, v = jnp.split(hg, [DIL_Q_DIM, DIL_Q_DIM + DIL_KV_DIM], axis=-1)
        q = rope(q.reshape(b, s, DIL_Q_HEADS, HEAD_DIM), positions)
        k = rope(k.reshape(b, s, DIL_KV_HEADS, HEAD_DIM), positions)
        v = v.reshape(b, s, DIL_KV_HEADS, HEAD_DIM)
        o, lse = dilated_attention(q, k, v, window, dil)
        outs.append(o)
        lses.append(lse)
    wts = jax.nn.softmax(jnp.stack(lses), axis=0)
    c_out = jnp.sum(wts[..., None] * jnp.stack(outs).astype(jnp.float32), axis=0).astype(x.dtype)
    hd, gate_b, gate_c = jnp.split(h[..., C_IN:], 3, axis=-1)
    d_out = short_conv(hd, gate_b, gate_c, conv_w)
    return jnp.concatenate([c_out.reshape(b, s, DIL_Q_DIM), d_out], -1) @ w_out


def swiglu(x, w_gate, w_up, w_down):
    return (jax.nn.silu(x @ w_gate) * (x @ w_up)) @ w_down


def moe_swiglu(x, w_router, w_gate, w_up, w_down):
    b, s, d = x.shape
    xt = x.reshape(-1, d)
    T = xt.shape[0]
    logits = (xt @ w_router).astype(jnp.float32)
    top_logit, top_e = lax.top_k(logits, TOP_K)
    gates = jax.nn.softmax(top_logit, axis=-1)
    e_flat = top_e.reshape(-1)
    g_flat = gates.reshape(-1)
    tok_flat = jnp.arange(T * TOP_K, dtype=jnp.int32) // TOP_K
    order = jnp.argsort(e_flat)
    e_sorted = e_flat[order]
    counts = jnp.bincount(e_flat, length=N_EXPERTS)
    padded = (counts + MOE_BLOCK - 1) // MOE_BLOCK * MOE_BLOCK
    start = jnp.cumsum(counts) - counts
    pend = jnp.cumsum(padded)
    pstart = pend - padded
    dest = pstart[e_sorted] + jnp.arange(T * TOP_K) - start[e_sorted]
    n_rows = -(-(T * TOP_K + N_EXPERTS * (MOE_BLOCK - 1)) // MOE_BLOCK) * MOE_BLOCK
    n_blocks = n_rows // MOE_BLOCK
    row_tok = jnp.full((n_rows,), T, jnp.int32).at[dest].set(tok_flat[order])
    row_gate = jnp.zeros((n_rows,), jnp.float32).at[dest].set(g_flat[order])
    block_e = jnp.minimum(jnp.searchsorted(pend, jnp.arange(n_blocks) * MOE_BLOCK, side='right'), N_EXPERTS - 1)
    xrows = jnp.concatenate([xt, jnp.zeros((1, d), xt.dtype)], 0)[row_tok].reshape(n_blocks, MOE_BLOCK, d)

    def expert_block(args):
        xb, e = args
        return (jax.nn.silu(xb @ w_gate[e]) * (xb @ w_up[e])) @ w_down[e]

    y = lax.map(expert_block, (xrows, block_e)).reshape(n_rows, d)
    out = jnp.zeros((T + 1, d), jnp.float32).at[row_tok].add(y.astype(jnp.float32) * row_gate[:, None])
    return out[:T].astype(x.dtype).reshape(b, s, d)


def setup_inputs(seed: int = 0) -> dict:
    key = jax.random.key(seed)
    ks = jax.random.split(key, 20)
    f32 = jnp.float32

    def nrm(k, shape, fan_in, gain=1.0):
        return jax.random.normal(k, shape, f32) * (gain * fan_in ** -0.5)

    x = jax.random.normal(ks[0], (BATCH, SEQ, D_MODEL), f32)
    offsets = jax.random.randint(ks[1], (BATCH, 1), 0, SEQ, jnp.int32)
    positions = offsets + jnp.arange(SEQ, dtype=jnp.int32)[None, :]
    ln_w = 1.0 + 0.02 * jax.random.normal(ks[2], (DEPTH, 2, D_MODEL), f32)
    ln_b = 0.02 * jax.random.normal(ks[3], (DEPTH, 2, D_MODEL), f32)
    even_w_in = nrm(ks[4], (N_EVEN, D_MODEL, EVEN_IN), D_MODEL)
    pool_w = nrm(ks[5], (N_EVEN, len(POOL_WINDOWS), POOL_GROUP, POOL_GROUP), POOL_GROUP)
    pool_scale = 1.0 + 0.02 * jax.random.normal(ks[6], (N_EVEN, POOL_WIDTH), f32)
    swa_sinks = 0.5 * jax.random.normal(ks[7], (N_EVEN, SWA_Q_HEADS), f32)
    even_w_out = nrm(ks[8], (N_EVEN, EVEN_MIX, D_MODEL), EVEN_MIX, BETA)
    ffn_w_gate = nrm(ks[9], (N_EVEN, D_MODEL, D_FF), D_MODEL)
    ffn_w_up = nrm(ks[10], (N_EVEN, D_MODEL, D_FF), D_MODEL)
    ffn_w_down = nrm(ks[11], (N_EVEN, D_FF, D_MODEL), D_FF, BETA)
    odd_w_in = nrm(ks[12], (N_ODD, D_MODEL, ODD_IN), D_MODEL)
    conv_w = nrm(ks[13], (N_ODD, CONV_K, CONV_WIDTH), CONV_K)
    odd_w_out = nrm(ks[14], (N_ODD, ODD_MIX, D_MODEL), ODD_MIX, BETA)
    router_w = nrm(ks[15], (N_ODD, D_MODEL, N_EXPERTS), D_MODEL)
    moe_w_gate = nrm(ks[16], (N_ODD, N_EXPERTS, D_MODEL, D_FF_EXPERT), D_MODEL)
    moe_w_up = nrm(ks[17], (N_ODD, N_EXPERTS, D_MODEL, D_FF_EXPERT), D_MODEL)
    moe_w_down = nrm(ks[18], (N_ODD, N_EXPERTS, D_FF_EXPERT, D_MODEL), D_FF_EXPERT, BETA)
    return {'x': x, 'positions': positions, 'ln_w': ln_w, 'ln_b': ln_b,
            'even_w_in': even_w_in, 'pool_w': pool_w, 'pool_scale': pool_scale, 'swa_sinks': swa_sinks,
            'even_w_out': even_w_out, 'ffn_w_gate': ffn_w_gate, 'ffn_w_up': ffn_w_up, 'ffn_w_down': ffn_w_down,
            'odd_w_in': odd_w_in, 'conv_w': conv_w, 'odd_w_out': odd_w_out, 'router_w': router_w,
            'moe_w_gate': moe_w_gate, 'moe_w_up': moe_w_up, 'moe_w_down': moe_w_down}


def reference(x, positions, ln_w, ln_b, even_w_in, pool_w, pool_scale, swa_sinks, even_w_out,
              ffn_w_gate, ffn_w_up, ffn_w_down, odd_w_in, conv_w, odd_w_out, router_w,
              moe_w_gate, moe_w_up, moe_w_down):
    for layer in range(DEPTH):
        i = layer // 2
        if layer % 2 == 0:
            mix = even_mixer(x, positions, even_w_in[i], pool_w[i], pool_scale[i], swa_sinks[i], even_w_out[i])
        else:
            mix = odd_mixer(x, positions, odd_w_in[i], conv_w[i], odd_w_out[i])
        x = layer_norm(ALPHA * x + mix, ln_w[layer, 0], ln_b[layer, 0])
        if layer % 2 == 0:
            ffn = swiglu(x, ffn_w_gate[i], ffn_w_up[i], ffn_w_down[i])
        else:
            ffn = moe_swiglu(x, router_w[i], moe_w_gate[i], moe_w_up[i], moe_w_down[i])
        x = layer_norm(ALPHA * x + ffn, ln_w[layer, 1], ln_b[layer, 1])
    return x
```

```cpp
#include <hip/hip_runtime.h>
#include <cstdio>
#include <cstdint>

#define GAS __attribute__((address_space(1)))
#define LAS __attribute__((address_space(3)))
typedef unsigned short bf16;
typedef short bf16x8 __attribute__((ext_vector_type(8)));
typedef short s16x4 __attribute__((ext_vector_type(4)));
typedef float f32x4 __attribute__((ext_vector_type(4)));
typedef float f32x16 __attribute__((ext_vector_type(16)));
typedef float f32x2 __attribute__((ext_vector_type(2)));
typedef unsigned u32x4 __attribute__((ext_vector_type(4)));
typedef unsigned u32x2 __attribute__((ext_vector_type(2)));
typedef GAS unsigned gu32;
typedef int v4i_t __attribute__((ext_vector_type(4)));
typedef int v8i_t __attribute__((ext_vector_type(8)));

#ifndef MK_PER_PHASE
#define MK_PER_PHASE 0
#endif

constexpr int NB = 8, SEQ = 4096, T = NB * SEQ, D = 1024;
constexpr int EVEN_IN = 1536, ODD_IN = 3840, DFF = 2816, DFFE = 3584, NE = 8;
constexpr float ALPHA = 1.41421356237309515f;
constexpr float LN_EPS = 1e-5f;
constexpr float C2 = 0.125f * 1.4426950408889634f;
constexpr float LOG2E = 1.4426950408889634f;
constexpr int NWAVES = 8;
constexpr int MAXTILES = 264;
constexpr float W1_SCALE = 32.f, W2_SCALE = 128.f, H_SCALE = 4.f, M_SCALE = 2.f, OG_SCALE = 8.f, Y_SCALE = 16.f;

constexpr size_t MiB = 1u << 20;
constexpr size_t WS_CTL = 0, CTL_ZERO_BYTES = 32 * 1024;
constexpr size_t WS_POOLWT = 1 * MiB;
constexpr size_t WS_LIST = 2 * MiB;
constexpr size_t WS_TOKINFO = 3 * MiB;
constexpr size_t WS_LSE = 4 * MiB;
constexpr size_t WS_WOOUT = 8 * MiB;
constexpr size_t WS_XB = 10 * MiB;
constexpr size_t WS_ROPE = 74 * MiB;
constexpr size_t WS_WEIN = 82 * MiB;
constexpr size_t WS_WEOUT = 85 * MiB;
constexpr size_t WS_WGU = 87 * MiB;
constexpr size_t WS_WDN = 98 * MiB;
constexpr size_t WS_WOIN = 104 * MiB;
constexpr size_t WS_BIG = 112 * MiB;
constexpr size_t WS_H0 = WS_BIG;
constexpr size_t WS_M0 = WS_BIG + 96 * MiB;
constexpr size_t WS_HF = WS_BIG;
constexpr size_t WS_H1 = WS_BIG;
constexpr size_t WS_M1 = WS_BIG + 240 * MiB;
constexpr size_t WS_OG = WS_BIG + 304 * MiB;
constexpr size_t DO_X8 = 0;
constexpr size_t DO_WM8 = 32 * MiB;
constexpr size_t DO_WMD8 = DO_WM8 + 56 * MiB;
constexpr size_t WS_Y = 112 * MiB;
constexpr size_t WS_HC8 = 244 * MiB;
constexpr size_t WS_Y2 = 476 * MiB;
constexpr int Y2_TILE0 = (int)((WS_Y2 - WS_Y) / ((size_t)256 * D));
constexpr size_t WS_END = 512 * MiB;
constexpr int CW_TMO = 0, CW_CODE = 1;
constexpr int CW_CNT = 1024;
constexpr int CW_BAR = 4096;

constexpr int RING_BYTES = 131072;
constexpr int LDSCTL_OFF = RING_BYTES, MISC_OFF = LDSCTL_OFF + 320;
constexpr int TAB_OFF = MISC_OFF + 128 + 64;
constexpr int ROPEC_OFF = 135168;
constexpr int TOK_OFF = ROPEC_OFF + 256;
constexpr int LDS_BYTES = 147456;

#define RLX_AGENT __ATOMIC_RELAXED, __HIP_MEMORY_SCOPE_AGENT
#define LDS_WAIT() asm volatile("s_waitcnt lgkmcnt(0)" ::: "memory")
#define VM_WAIT() asm volatile("s_waitcnt vmcnt(0)" ::: "memory")

__device__ __forceinline__ float bf2f(unsigned short b) { return __uint_as_float((unsigned)b << 16); }
__device__ __forceinline__ unsigned f2bf(float f) { unsigned u = __float_as_uint(f); return (u + 0x7fffu + ((u >> 16) & 1u)) >> 16; }
__device__ __forceinline__ unsigned pk2(float lo, float hi) { return f2bf(lo) | (f2bf(hi) << 16); }
typedef __bf16 bf16x2_t __attribute__((ext_vector_type(2)));
__device__ __forceinline__ unsigned cvtpk(float lo, float hi) { f32x2 v = {lo, hi}; bf16x2_t b = __builtin_convertvector(v, bf16x2_t); return __builtin_bit_cast(unsigned, b); }
__device__ __forceinline__ float wave_sum(float v) {
#pragma unroll
    for (int o = 1; o < 64; o <<= 1) v += __shfl_xor(v, o);
    return v;
}

template <int MAP> __host__ __device__ __forceinline__ int dest_row(int n) {
    if (MAP == 0) return n;
    if (MAP == 4) { const int g = n & ~31, i = n & 31, fq = i >> 3, nn = (i >> 2) & 1, e = i & 3; return g + 16 * nn + 4 * fq + e; }
    if (MAP == 1) { const int tile = n >> 8, c = n & 255, hd = c >> 6, half = (c >> 5) & 1, i = c & 31;
        const int bj = hd >> 1, wc = 2 * (hd & 1) + (i >> 4), fq = (i >> 2) & 3, e = i & 3;
        return 256 * tile + 128 * bj + 32 * wc + 16 * half + 4 * fq + e; }
    const int which = MAP - 2, tile = n >> 7, jj = n & 127, wc = jj >> 5, fq = (jj >> 3) & 3, bj = (jj >> 2) & 1, e = jj & 3;
    return 256 * tile + 128 * bj + 32 * wc + 16 * which + 4 * fq + e;
}

namespace pg8 {
constexpr int BM = 256, BK = 64, HALF = 128, HTB = HALF * BK * 2, STAGE_BYTES = 8 * HTB, NXCD = 8, WGM = 8;
__host__ __device__ __forceinline__ int lds_byte(int r, int c) { const int st = (r >> 4) * 2 + (c >> 5), rr = r & 15, cc = c & 31, ob = rr * 64 + cc * 2; return st * 1024 + (ob ^ (((ob >> 9) & 1) << 5)); }
__host__ __device__ __forceinline__ void stage_rc(int b, int& R, int& C) { const int st = b / 1024, sb = b % 1024, swz = sb ^ (((sb >> 9) & 1) << 5); R = (st >> 1) * 16 + swz / 64; C = (st & 1) * 32 + (swz % 64) / 2; }
struct Unit { int pm, pn; };
struct StaticOrder {
    int nM, nN, nwg, G, c;
    __host__ __device__ void init(int nM_, int nN_, int G_, int c_) { nM = nM_; nN = nN_; nwg = nM * nN; G = G_; c = c_; }
    __host__ __device__ bool next(int i, Unit& u) const {
        const long L = (long)i * G + c; if (L >= nwg) return false;
        int wgid = (int)L; { const int q = nwg / NXCD, r = nwg % NXCD, xcd = wgid % NXCD, off = wgid / NXCD; wgid = (xcd < r ? xcd * (q + 1) : r * (q + 1) + (xcd - r) * q) + off; }
        const int nig = WGM * nN, gid = wgid / nig, fm = gid * WGM, gsz = (nM - fm) < WGM ? (nM - fm) : WGM;
        u.pm = fm + ((wgid % nig) % gsz); u.pn = (wgid % nig) / gsz; return true;
    }
};
struct PlainSched {
    static constexpr bool VAR_NT = false;
    StaticOrder so; const char* A; const char* B; size_t tstep; int rev = 0;
    __device__ __forceinline__ bool next(int i, Unit& u) const { const bool ok = so.next(i, u); if (rev) u.pm = so.nM - 1 - u.pm; return ok; }
    __device__ __forceinline__ const char* a_base(const Unit& u) const { return A + (size_t)u.pm * tstep; }
    __device__ __forceinline__ const char* b_base(const Unit& u) const { return B + (size_t)u.pn * tstep; }
    __device__ __forceinline__ void a_rows(const Unit&, int, const int (&)[2], const int (&)[2], unsigned (&)[2][2]) const {}
};

template <class Epi> struct gate_shift { static constexpr int value = 0; };
template <bool GATHER, bool FP8, class Epi, class Sched>
__device__ __forceinline__ void gemm_phase(LAS unsigned char* lds, const int K, const Sched& S, const Epi& E, const int nt_part = 0) {
    const int tid = threadIdx.x, wid = __builtin_amdgcn_readfirstlane(tid >> 6), lane = tid & 63, wr = wid >> 2, wc = wid & 3, fr = lane & 15, fq = lane >> 4;
    int nt = nt_part ? nt_part : K / BK;
    unsigned voffA[2], voffB[2]; int Rr[2], Cc[2];
#pragma unroll
    for (int i = 0; i < 2; ++i) { int R, C; stage_rc(tid * 16 + i * 8192, R, C); Rr[i] = R; Cc[i] = C; voffA[i] = (unsigned)(R * K + C) * 2u; voffB[i] = voffA[i]; }
    const size_t kstep = (size_t)(BK * 2);
    const size_t hstep = (size_t)HALF * K * 2;
    const unsigned ldsw = (unsigned)wid * 1024u;
    const int aoff = lds_byte(wr * 64 + fr, fq * 8), boff = lds_byte(wc * 32 + fr, fq * 8);
    unsigned vA[2][2], vAn[2][2];
#define PG8_SA(b, h) (((b) * 2 + (h)) * HTB)
#define PG8_SB(b, h) ((4 + (b) * 2 + (h)) * HTB)
#define PG8_STAGE(bufoff, gbase, voff) do { _Pragma("unroll") for (int _i = 0; _i < 2; ++_i) \
        __builtin_amdgcn_global_load_lds((const unsigned*)((const char*)(gbase) + (voff)[_i]), (LAS unsigned*)(lds + (bufoff) + ldsw + _i * 8192), 16, 0, 0); } while (0)
#define PG8_STA(bufoff, kptr, h, useN) do { if constexpr (GATHER) { _Pragma("unroll") for (int _i = 0; _i < 2; ++_i) { const unsigned _o = (useN) ? vAn[h][_i] : vA[h][_i]; \
        __builtin_amdgcn_global_load_lds((const unsigned*)((const char*)(kptr) + _o), (LAS unsigned*)(lds + (bufoff) + ldsw + _i * 8192), 16, 0, 0); } } \
        else { PG8_STAGE(bufoff, (kptr) + (h) * hstep, voffA); } } while (0)
#define PG8_LDA(dst, b, h) do { _Pragma("unroll") for (int m = 0; m < 4; ++m) _Pragma("unroll") for (int k = 0; k < 2; ++k) dst[m][k] = *(const LAS bf16x8*)(lds + PG8_SA(b, h) + aoff + m * 2048 + k * 1024); } while (0)
#define PG8_LDB(dst, b, h) do { _Pragma("unroll") for (int n = 0; n < 2; ++n) _Pragma("unroll") for (int k = 0; k < 2; ++k) dst[n][k] = *(const LAS bf16x8*)(lds + PG8_SB(b, h) + boff + n * 2048 + k * 1024); } while (0)
#define PG8_MMA(ai, bj, At, Bt) do { __builtin_amdgcn_s_setprio(1); _Pragma("unroll") for (int m = 0; m < 4; ++m) _Pragma("unroll") for (int n = 0; n < 2; ++n) _Pragma("unroll") for (int k = 0; k < 2; ++k) \
        asm volatile("v_mfma_f32_16x16x32_bf16 %0, %1, %2, %0" : "+v"(acc[ai][bj][m][n]) : "v"(Bt[n][k]), "v"(At[m][k])); __builtin_amdgcn_s_setprio(0); } while (0)
#define PG8_LD8(p) __builtin_shufflevector(*(const LAS v4i_t*)(p), *(const LAS v4i_t*)((p) + 1024), 0, 1, 2, 3, 4, 5, 6, 7)
#define PG8_LDA8(dst, b, h) do { _Pragma("unroll") for (int m = 0; m < 4; ++m) dst[m] = PG8_LD8(lds + PG8_SA(b, h) + aoff + m * 2048); } while (0)
#define PG8_LDB8(dst, b, h) do { _Pragma("unroll") for (int n = 0; n < 2; ++n) dst[n] = PG8_LD8(lds + PG8_SB(b, h) + boff + n * 2048); } while (0)
#define PG8_MMA8(ai, bj, At, Bt) do { __builtin_amdgcn_s_setprio(1); _Pragma("unroll") for (int m = 0; m < 4; ++m) _Pragma("unroll") for (int n = 0; n < 2; ++n) \
        asm volatile("v_mfma_scale_f32_16x16x128_f8f6f4 %0, %1, %2, %0, %3, %4 op_sel_hi:[0,0,0]" : "+v"(acc[ai][bj][m][n]) : "v"(Bt[n]), "v"(At[m]), "v"(n == 0 ? gsc8 : one8), "v"(one8)); __builtin_amdgcn_s_setprio(0); } while (0)
#define PG8_MMA8F(ai, bj, At, Bt) do { __builtin_amdgcn_s_setprio(1); _Pragma("unroll") for (int m = 0; m < 4; ++m) _Pragma("unroll") for (int n = 0; n < 2; ++n) \
        asm volatile("v_mfma_scale_f32_16x16x128_f8f6f4 %0, %1, %2, 0, %3, %4 op_sel_hi:[0,0,0]" : "+v"(acc[ai][bj][m][n]) : "v"(Bt[n]), "v"(At[m]), "v"(n == 0 ? gsc8 : one8), "v"(one8)); __builtin_amdgcn_s_setprio(0); } while (0)
#define PG8_MM(ai, bj, At_, B_) do { if constexpr (FP8) PG8_MMA8(ai, bj, At8, B_##8); else PG8_MMA(ai, bj, At_, B_); } while (0)
#define PG8_MMAF(ai, bj, At, Bt) do { __builtin_amdgcn_s_setprio(1); _Pragma("unroll") for (int m = 0; m < 4; ++m) _Pragma("unroll") for (int n = 0; n < 2; ++n) { \
        asm volatile("v_mfma_f32_16x16x32_bf16 %0, %1, %2, 0" : "+v"(acc[ai][bj][m][n]) : "v"(Bt[n][0]), "v"(At[m][0])); asm volatile("v_mfma_f32_16x16x32_bf16 %0, %1, %2, %0" : "+v"(acc[ai][bj][m][n]) : "v"(Bt[n][1]), "v"(At[m][1])); } \
        __builtin_amdgcn_s_setprio(0); } while (0)
#define PG8_MM0(ai, bj, At_, B_) do { if constexpr (FP8) PG8_MMA8F(ai, bj, At8, B_##8); else PG8_MMAF(ai, bj, At_, B_); } while (0)
#define PG8_LA(At_, b, h) do { if constexpr (FP8) PG8_LDA8(At8, b, h); else PG8_LDA(At_, b, h); } while (0)
#define PG8_LB(B_, b, h) do { if constexpr (FP8) PG8_LDB8(B_##8, b, h); else PG8_LDB(B_, b, h); } while (0)
#define PG8_WAIT_V(n) asm volatile("s_waitcnt vmcnt(" #n ")" ::: "memory")
#define PG8_WAIT_L(n) asm volatile("s_waitcnt lgkmcnt(" #n ")" ::: "memory")
#define PG8_BAR __builtin_amdgcn_s_barrier()
#define PG8_SCHED __builtin_amdgcn_sched_barrier(0)
    Unit cur, nxt; int ui = 0;
    if (!S.next(0, cur)) return;
    f32x4 acc[2][2][4][2];
#pragma unroll
    for (int a = 0; a < 2; ++a)
#pragma unroll
        for (int b = 0; b < 2; ++b)
#pragma unroll
            for (int m = 0; m < 4; ++m)
#pragma unroll
                for (int n = 0; n < 2; ++n) { asm volatile("" : "=v"(acc[a][b][m][n])); }
    bf16x8 At[4][2], B0[2][2], B1[2][2]; v8i_t At8[4], B08[2], B18[2]; int one8 = 0x7f7f7f7f; asm volatile("" : "+v"(one8));
    int gsc8 = 0x7f7f7f7f - 0x01010101 * gate_shift<Epi>::value; asm volatile("" : "+v"(gsc8));
    const char* cA = S.a_base(cur); const char* cB = S.b_base(cur);
    if constexpr (GATHER) { S.a_rows(cur, K, Rr, Cc, vA); }
    PG8_STAGE(PG8_SB(0, 0), cB, voffB); PG8_STAGE(PG8_SB(0, 1), cB + hstep, voffB); PG8_STA(PG8_SA(0, 0), cA, 0, false); PG8_STA(PG8_SA(0, 1), cA, 1, false);
    if (wr == 1) PG8_BAR;
    PG8_WAIT_V(2); PG8_BAR;
    PG8_STAGE(PG8_SB(1, 0), cB + kstep, voffB); PG8_STA(PG8_SA(1, 0), cA + kstep, 0, false); PG8_STAGE(PG8_SB(1, 1), cB + hstep + kstep, voffB);
    PG8_WAIT_V(6); PG8_BAR;
    for (;;) {
        if constexpr (Sched::VAR_NT) nt = S.ktiles(cur);
        bool has_next = false; const char* nA = cA; const char* nB = cB;
#define PG8_NEXT_UNIT() do { has_next = S.next(ui + 1, nxt); nA = has_next ? S.a_base(nxt) : cA; nB = has_next ? S.b_base(nxt) : cB; \
            if constexpr (GATHER) { if (has_next && wid < 4) __builtin_amdgcn_global_load_lds((const unsigned*)S.tok_addr(nxt, tid), (LAS unsigned*)(lds + TOK_OFF + wid * 256), 4, 0, 0); } } while (0)
#define PG8_NEXT_ROWS() do { if constexpr (GATHER) { if (has_next) { \
                _Pragma("unroll") for (int h = 0; h < 2; ++h) _Pragma("unroll") for (int i = 0; i < 2; ++i) { const int tk = *(const LAS int*)(lds + TOK_OFF + 4 * (128 * h + Rr[i])); vAn[h][i] = (unsigned)(tk * K + Cc[i]) * 2u; } } \
            else { _Pragma("unroll") for (int h = 0; h < 2; ++h) _Pragma("unroll") for (int i = 0; i < 2; ++i) vAn[h][i] = vA[h][i]; } } } while (0)
#define PG8_TRIP(t, MMX, HOOK) do { \
            const bool last = ((t) == nt - 2); \
            const char* a1 = cA + (size_t)((t) + 1) * kstep; \
            const char* a2 = last ? nA : cA + (size_t)((t) + 2) * kstep; const char* b2 = last ? nB : cB + (size_t)((t) + 2) * kstep; \
            const char* a3 = a2 + kstep; const char* b3 = b2 + kstep; \
              \
            PG8_LB(B0, 0, 0); PG8_LB(B1, 0, 1); PG8_SCHED; PG8_LA(At, 0, 0); PG8_STA(PG8_SA(1, 1), a1, 1, false); \
            PG8_WAIT_V(8); PG8_WAIT_L(0); PG8_BAR; MMX(0, 0, At, B0); MMX(0, 1, At, B1); PG8_BAR; PG8_SCHED; HOOK; PG8_SCHED; \
              \
            PG8_LA(At, 0, 1); PG8_STAGE(PG8_SB(0, 0), b2, voffB); PG8_STAGE(PG8_SB(0, 1), b2 + hstep, voffB); PG8_STA(PG8_SA(0, 0), a2, 0, last); \
            PG8_WAIT_V(8); PG8_WAIT_L(0); PG8_BAR; MMX(1, 0, At, B0); MMX(1, 1, At, B1); PG8_BAR; PG8_SCHED; \
              \
            PG8_LB(B0, 1, 0); PG8_LB(B1, 1, 1); PG8_SCHED; PG8_LA(At, 1, 0); PG8_STA(PG8_SA(0, 1), a2, 1, last); \
            PG8_WAIT_V(8); PG8_WAIT_L(0); PG8_BAR; PG8_MM(0, 0, At, B0); PG8_MM(0, 1, At, B1); PG8_BAR; PG8_SCHED; \
              \
            PG8_LA(At, 1, 1); PG8_STAGE(PG8_SB(1, 0), b3, voffB); PG8_STAGE(PG8_SB(1, 1), b3 + hstep, voffB); PG8_STA(PG8_SA(1, 0), a3, 0, last); \
            PG8_WAIT_V(8); PG8_WAIT_L(0); PG8_BAR; PG8_MM(1, 0, At, B0); PG8_MM(1, 1, At, B1); PG8_BAR; PG8_SCHED; } while (0)
        PG8_TRIP(0, PG8_MM0, PG8_NEXT_UNIT());
        for (int t = 2; t < nt; t += 2) PG8_TRIP(t, PG8_MM, if (last) PG8_NEXT_ROWS());
#undef PG8_TRIP
#undef PG8_NEXT_UNIT
#undef PG8_NEXT_ROWS
        if (wr == 0) PG8_BAR;
        asm volatile("s_nop 15\n\ts_nop 15" ::: "memory");
        E(acc, cur, wr, wc, fr, fq);
        if (!has_next) break;
#pragma unroll
        for (int a = 0; a < 2; ++a)
#pragma unroll
            for (int b = 0; b < 2; ++b)
#pragma unroll
                for (int m = 0; m < 4; ++m)
#pragma unroll
                    for (int n = 0; n < 2; ++n) { asm volatile("" : "=v"(acc[a][b][m][n])); }
        cur = nxt; cA = nA; cB = nB; ++ui;
        if constexpr (GATHER) {
#pragma unroll
            for (int h = 0; h < 2; ++h)
#pragma unroll
                for (int i = 0; i < 2; ++i) vA[h][i] = vAn[h][i]; }
        if (wr == 1) PG8_BAR;
    }
    PG8_WAIT_V(0);
    PG8_BAR;
#undef PG8_SA
#undef PG8_SB
#undef PG8_STAGE
#undef PG8_STA
#undef PG8_LDA
#undef PG8_LDB
#undef PG8_MMA
#undef PG8_MMA8
#undef PG8_MMA8F
#undef PG8_MMAF
#undef PG8_MM0
#undef PG8_MM
#undef PG8_LD8
#undef PG8_LDA8
#undef PG8_LDB8
#undef PG8_LA
#undef PG8_LB
#undef PG8_WAIT_V
#undef PG8_WAIT_L
#undef PG8_BAR
#undef PG8_SCHED
}
}

__device__ __forceinline__ f32x4 silu_mul4(f32x4 g, f32x4 up) {
    const f32x2 g0 = {g[0], g[1]}, g1 = {g[2], g[3]}, u0 = {up[0], up[1]}, u1 = {up[2], up[3]};
    const f32x2 t0 = g0 * (-LOG2E), t1 = g1 * (-LOG2E);
    f32x2 e0, e1; e0.x = __builtin_amdgcn_exp2f(t0.x); e0.y = __builtin_amdgcn_exp2f(t0.y); e1.x = __builtin_amdgcn_exp2f(t1.x); e1.y = __builtin_amdgcn_exp2f(t1.y);
    const f32x2 d0 = e0 + 1.0f, d1 = e1 + 1.0f;
    f32x2 r0, r1; r0.x = __builtin_amdgcn_rcpf(d0.x); r0.y = __builtin_amdgcn_rcpf(d0.y); r1.x = __builtin_amdgcn_rcpf(d1.x); r1.y = __builtin_amdgcn_rcpf(d1.y);
    const f32x2 h0 = (g0 * u0) * r0, h1 = (g1 * u1) * r1;
    return (f32x4){h0.x, h0.y, h1.x, h1.y};
}
template <bool FP8ACC>
__device__ __forceinline__ f32x4 silu_mul4_scaled(f32x4 ag, f32x4 au) {
    constexpr float KT = FP8ACC ? -1.0f : -LOG2E, KD = FP8ACC ? LOG2E * W1_SCALE / H_SCALE : 1.0f / H_SCALE;
    const f32x2 g0 = {ag[0], ag[1]}, g1 = {ag[2], ag[3]}, u0 = {au[0], au[1]}, u1 = {au[2], au[3]};
    const f32x2 t0 = g0 * KT, t1 = g1 * KT;
    f32x2 e0, e1; e0.x = __builtin_amdgcn_exp2f(t0.x); e0.y = __builtin_amdgcn_exp2f(t0.y); e1.x = __builtin_amdgcn_exp2f(t1.x); e1.y = __builtin_amdgcn_exp2f(t1.y);
    const f32x2 d0 = e0 * KD + KD, d1 = e1 * KD + KD;
    f32x2 r0, r1; r0.x = __builtin_amdgcn_rcpf(d0.x); r0.y = __builtin_amdgcn_rcpf(d0.y); r1.x = __builtin_amdgcn_rcpf(d1.x); r1.y = __builtin_amdgcn_rcpf(d1.y);
    const f32x2 h0 = (g0 * u0) * r0, h1 = (g1 * u1) * r1;
    return (f32x4){h0.x, h0.y, h1.x, h1.y};
}
struct EpiSwiglu {
    bf16* out; int ldh;
    __device__ __forceinline__ void operator()(const f32x4 (&acc)[2][2][4][2], const pg8::Unit& u, int wr, int wc, int fr, int fq) const {
#pragma unroll
        for (int ai = 0; ai < 2; ++ai)
#pragma unroll
            for (int m = 0; m < 4; ++m) {
                const int row = u.pm * 256 + ai * 128 + wr * 64 + m * 16 + fr;
                u32x4 w;
#pragma unroll
                for (int bj = 0; bj < 2; ++bj) {
                    const f32x4 g = acc[ai][bj][m][0], up = acc[ai][bj][m][1]; f32x4 h;
                    h = silu_mul4(g, up);
                    if (bj == 0) { w.x = cvtpk(h[0], h[1]); w.y = cvtpk(h[2], h[3]); } else { w.z = cvtpk(h[0], h[1]); w.w = cvtpk(h[2], h[3]); }
                }
                *(GAS u32x4*)(out + (size_t)row * ldh + u.pn * 128 + wc * 32 + fq * 8) = w;
            }
    }
};
__device__ __forceinline__ unsigned pk4_fp8(float a, float b, float c, float d) { int p = __builtin_amdgcn_cvt_pk_fp8_f32(a, b, 0, false); p = __builtin_amdgcn_cvt_pk_fp8_f32(c, d, p, true); return (unsigned)p; }
template <bool SCALED>
struct EpiSwiglu8 {
    unsigned char* out; int ldh;
    __device__ __forceinline__ void operator()(const f32x4 (&acc)[2][2][4][2], const pg8::Unit& u, int wr, int wc, int fr, int fq) const {
#pragma unroll
        for (int ai = 0; ai < 2; ++ai)
#pragma unroll
            for (int m = 0; m < 4; ++m) {
                const int row = u.pm * 256 + ai * 128 + wr * 64 + m * 16 + fr;
                u32x2 w;
#pragma unroll
                for (int bj = 0; bj < 2; ++bj) {
                    f32x4 h;
                    h = silu_mul4_scaled<SCALED>(acc[ai][bj][m][0], acc[ai][bj][m][1]);
                    const unsigned p = pk4_fp8(h[0], h[1], h[2], h[3]);
                    if (bj == 0) w.x = p; else w.y = p;
                }
                *(GAS u32x2*)(out + (size_t)row * ldh + u.pn * 128 + wc * 32 + fq * 8) = w;
            }
    }
};
namespace pg8 { template <> struct gate_shift<EpiSwiglu8<true>> { static constexpr int value = 5; }; }
__device__ __forceinline__ f32x4 bf_lo4(u32x2 v) { return (f32x4){__uint_as_float(v.x << 16), __uint_as_float(v.x & 0xffff0000u), __uint_as_float(v.y << 16), __uint_as_float(v.y & 0xffff0000u)}; }
template <bool SC>
struct EpiResidT {
    bf16* xb; float sc;
    __device__ __forceinline__ void operator()(const f32x4 (&acc)[2][2][4][2], const pg8::Unit& u, int wr, int wc, int fr, int fq) const {
        bf16* p0 = xb + (size_t)(u.pm * 256 + wr * 64 + fr) * D + u.pn * 256 + wc * 32 + 8 * fq;
        u32x4 r[2][4][2];
#pragma unroll
        for (int ai = 0; ai < 2; ++ai)
#pragma unroll
            for (int m = 0; m < 4; ++m)
#pragma unroll
                for (int bj = 0; bj < 2; ++bj) r[ai][m][bj] = *(const GAS u32x4*)(p0 + (size_t)(ai * 128 + m * 16) * D + bj * 128);
#pragma unroll
        for (int ai = 0; ai < 2; ++ai)
#pragma unroll
            for (int m = 0; m < 4; ++m)
#pragma unroll
                for (int bj = 0; bj < 2; ++bj) {
                    const u32x4 rr = r[ai][m][bj];
                    const f32x4 r0 = bf_lo4((u32x2){rr.x, rr.y}), r1 = bf_lo4((u32x2){rr.z, rr.w});
                    f32x4 o0, o1;
                    if constexpr (SC) { o0 = r0 * ALPHA + acc[ai][bj][m][0] * sc; o1 = r1 * ALPHA + acc[ai][bj][m][1] * sc; } else { o0 = r0 * ALPHA + acc[ai][bj][m][0]; o1 = r1 * ALPHA + acc[ai][bj][m][1]; }
                    u32x4 w; w.x = cvtpk(o0[0], o0[1]); w.y = cvtpk(o0[2], o0[3]); w.z = cvtpk(o1[0], o1[1]); w.w = cvtpk(o1[2], o1[3]);
                    *(GAS u32x4*)(p0 + (size_t)(ai * 128 + m * 16) * D + bj * 128) = w;
                }
    }
};
typedef EpiResidT<false> EpiResid;
struct EpiY {
    bf16* out; int row_off; float sc; int ldc;
    __device__ __forceinline__ void operator()(const f32x4 (&acc)[2][2][4][2], const pg8::Unit& u, int wr, int wc, int fr, int fq) const {
#pragma unroll
        for (int ai = 0; ai < 2; ++ai)
#pragma unroll
            for (int m = 0; m < 4; ++m) {
                bf16* p = out + (size_t)(row_off + u.pm * 256 + ai * 128 + wr * 64 + m * 16 + fr) * ldc + u.pn * 256 + wc * 32 + 8 * fq;
#pragma unroll
                for (int bj = 0; bj < 2; ++bj) {
                    const f32x4 o0 = acc[ai][bj][m][0] * sc, o1 = acc[ai][bj][m][1] * sc;
                    u32x4 w; w.x = cvtpk(o0[0], o0[1]); w.y = cvtpk(o0[2], o0[3]); w.z = cvtpk(o1[0], o1[1]); w.w = cvtpk(o1[2], o1[3]);
                    *(GAS u32x4*)(p + bj * 128) = w;
                }
            }
    }
};

struct EpiYConv {
    bf16* out;
    __device__ __forceinline__ void operator()(const f32x4 (&acc)[2][2][4][2], const pg8::Unit& u, int wr, int wc, int fr, int fq) const {
        if (u.pn >= 9 && u.pn < 13) {
#pragma unroll
            for (int ai = 0; ai < 2; ++ai)
#pragma unroll
                for (int m = 0; m < 4; ++m) {
                    const int row = u.pm * 256 + ai * 128 + wr * 64 + m * 16 + fr;
                    const f32x4 z0 = acc[ai][0][m][0] * acc[ai][0][m][1], z1 = acc[ai][1][m][0] * acc[ai][1][m][1];
                    u32x4 w; w.x = cvtpk(z0[0], z0[1]); w.y = cvtpk(z0[2], z0[3]); w.z = cvtpk(z1[0], z1[1]); w.w = cvtpk(z1[2], z1[3]);
                    *(GAS u32x4*)(out + (size_t)row * ODD_IN + 2304 + (u.pn - 9) * 128 + wc * 32 + fq * 8) = w;
                }
        } else {
            const int col0 = (u.pn < 9 ? u.pn * 256 : 2816 + (u.pn - 13) * 256) + wc * 32 + 8 * fq;
#pragma unroll
            for (int ai = 0; ai < 2; ++ai)
#pragma unroll
                for (int m = 0; m < 4; ++m) {
                    bf16* p = out + (size_t)(u.pm * 256 + ai * 128 + wr * 64 + m * 16 + fr) * ODD_IN + col0;
#pragma unroll
                    for (int bj = 0; bj < 2; ++bj) {
                        const f32x4 o0 = acc[ai][bj][m][0], o1 = acc[ai][bj][m][1];
                        u32x4 w; w.x = cvtpk(o0[0], o0[1]); w.y = cvtpk(o0[2], o0[3]); w.z = cvtpk(o1[0], o1[1]); w.w = cvtpk(o1[2], o1[3]);
                        *(GAS u32x4*)(p + bj * 128) = w;
                    }
                }
        }
    }
};
struct EpiY8 {
    unsigned char* out; float sc;
    __device__ __forceinline__ void operator()(const f32x4 (&acc)[2][2][4][2], const pg8::Unit& u, int wr, int wc, int fr, int fq) const {
#pragma unroll
        for (int ai = 0; ai < 2; ++ai)
#pragma unroll
            for (int m = 0; m < 4; ++m) {
                unsigned char* p = out + (size_t)(u.pm * 256 + ai * 128 + wr * 64 + m * 16 + fr) * D + u.pn * 256 + wc * 32 + 8 * fq;
#pragma unroll
                for (int bj = 0; bj < 2; ++bj) {
                    const f32x4 o0 = acc[ai][bj][m][0] * sc, o1 = acc[ai][bj][m][1] * sc;
                    u32x2 w; w.x = pk4_fp8(o0[0], o0[1], o0[2], o0[3]); w.y = pk4_fp8(o1[0], o1[1], o1[2], o1[3]);
                    *(GAS u32x2*)(p + bj * 128) = w;
                }
            }
    }
};

#define XB_TMO      128
#define XB_XCNT(j)  (256  + 64 * (j))
#define XB_XSUB(j)  (1280 + 64 * (j))
#define XB_XGEN(j)  (2304 + 64 * (j))
#define XB_TOP      3328
#define XB_TOPGEN   3392
#define XCD_BAR_WORDS 3456
#define XB_SPIN_CAP (1u << 18)
__device__ __forceinline__ unsigned xb_ld(unsigned* p)              { return __hip_atomic_load(p, __ATOMIC_RELAXED, __HIP_MEMORY_SCOPE_AGENT); }
__device__ __forceinline__ unsigned xb_add(unsigned* p, unsigned v) { return __hip_atomic_fetch_add(p, v, __ATOMIC_RELAXED, __HIP_MEMORY_SCOPE_AGENT); }
__device__ __forceinline__ unsigned xb_xcc_id() { return (unsigned)__builtin_amdgcn_s_getreg((3 << 11) | 20) & 0xFu; }
#define XB_SPIN(cond, bar) do { unsigned _sp = 0; while (cond) { __builtin_amdgcn_s_sleep(1); \
    if ((++_sp & 255u) == 0u) { if (xb_ld(&(bar)[XB_TMO])) break; if (_sp > XB_SPIN_CAP) { atomicAdd(&(bar)[XB_TMO], 1u); break; } } } } while (0)
struct XcdBarrier { unsigned* bar; unsigned x; volatile LAS unsigned* st; };
__device__ __forceinline__ XcdBarrier xcd_barrier_post(unsigned* bar, volatile LAS unsigned* st) {
    XcdBarrier b; b.bar = bar; b.x = xb_xcc_id(); b.st = st;
    if (threadIdx.x == 0) (void)xb_add(&bar[XB_XCNT(b.x)], 1u);
    return b;
}
__device__ __forceinline__ void xcd_barrier_complete(unsigned* bar, unsigned x, unsigned& nloc, unsigned& nx) {
    const unsigned G = gridDim.x * gridDim.y * gridDim.z;
    unsigned sum, cnt, mine, sp = 0u;
    for (;;) {
        sum = 0u; cnt = 0u; mine = 0u;
#pragma unroll
        for (unsigned j = 0; j < 16; ++j) { const unsigned c = xb_ld(&bar[XB_XCNT(j)]); sum += c; cnt += (c > 0u) ? 1u : 0u; mine = (j == x) ? c : mine; }
        if (sum == G) break;
        __builtin_amdgcn_s_sleep(1);
        if ((++sp & 255u) == 0u) { if (xb_ld(&bar[XB_TMO])) break; if (sp > XB_SPIN_CAP) { atomicAdd(&bar[XB_TMO], 1u); break; } }
    }
    nloc = mine > 0u ? mine : 1u; nx = cnt > 0u ? cnt : 1u;
}
__device__ __forceinline__ void xcd_barrier(const XcdBarrier& b) {
    asm volatile("s_waitcnt vmcnt(0)" ::: "memory");
    __syncthreads();
    if (threadIdx.x == 0) {
        unsigned* bar = b.bar;
        __builtin_amdgcn_s_waitcnt(0);
        unsigned nloc = b.st[0], nx = b.st[1];
        if (nloc == 0u) { xcd_barrier_complete(bar, b.x, nloc, nx); b.st[0] = nloc; b.st[1] = nx; }
        const unsigned old = xb_add(&bar[XB_XSUB(b.x)], 1u);
        const unsigned gen = old / nloc;
        if (old + 1u == (gen + 1u) * nloc) {
            __builtin_amdgcn_fence(__ATOMIC_RELEASE, "agent");
            asm volatile("s_waitcnt vmcnt(0)" ::: "memory");
            const unsigned og = xb_add(&bar[XB_TOP], 1u);
            const unsigned tg = og / nx;
            if (og + 1u == (tg + 1u) * nx) xb_add(&bar[XB_TOPGEN], 1u);
            else XB_SPIN(xb_ld(&bar[XB_TOPGEN]) == tg, bar);
            __builtin_amdgcn_fence(__ATOMIC_ACQUIRE, "agent");
            xb_add(&bar[XB_XGEN(b.x)], 1u);
            asm volatile("s_waitcnt vmcnt(0)" ::: "memory");
        } else {
            XB_SPIN(xb_ld(&bar[XB_XGEN(b.x)]) == gen, bar);
            __builtin_amdgcn_fence(__ATOMIC_ACQUIRE, "agent");
            asm volatile("s_waitcnt vmcnt(0)" ::: "memory");
        }
    }
    __syncthreads();
}

struct Frame {
    LAS unsigned char* lds;
    volatile LAS unsigned* MISC;
    gu32* ctl;
    int tid, lane, wave, vcu, G;
    const float* x; const int* pos; const float* ln_w; const float* ln_b;
    const float *even_w_in, *pool_w, *pool_scale, *sinks, *even_w_out, *ffn_wg, *ffn_wu, *ffn_wd, *odd_w_in, *conv_w, *odd_w_out, *router_w, *moe_wg, *moe_wu, *moe_wd;
    float* res;
    unsigned char* ws;
};

template <int MAP>
__device__ __forceinline__ void transpose_item(const float* W, int K, int N, bf16* WT, LAS float* scr, int item, int lane, int ldw = 0) {
    const int nblk = N / 32, kb = item / nblk, nb = item % nblk, k0 = 64 * kb, n0 = 32 * nb, ld = ldw ? ldw : N;
    float tv[32];
#pragma unroll
    for (int i = 0; i < 32; ++i) { const int kk = 2 * i + (lane >> 5); tv[i] = __builtin_nontemporal_load((const GAS float*)(W + (size_t)(k0 + kk) * ld + n0 + (lane & 31))); }
#pragma unroll
    for (int i = 0; i < 32; ++i) { const int kk = 2 * i + (lane >> 5); scr[kk * 33 + (lane & 31)] = tv[i]; }
    LDS_WAIT(); asm volatile("" ::: "memory");
    const int c = lane & 7;
#pragma unroll
    for (int j = 0; j < 4; ++j) { const int n = (lane >> 3) + 8 * j; const LAS float* s = scr + (8 * c) * 33 + n;
        u32x4 o; o.x = pk2(s[0 * 33], s[1 * 33]); o.y = pk2(s[2 * 33], s[3 * 33]); o.z = pk2(s[4 * 33], s[5 * 33]); o.w = pk2(s[6 * 33], s[7 * 33]);
        *(GAS u32x4*)(WT + (size_t)dest_row<MAP>(n0 + n) * K + k0 + 8 * c) = o; }
    LDS_WAIT(); asm volatile("" ::: "memory");
}

template <int MAP>
__device__ __forceinline__ void transpose_item8(const float* W, int K, int N, unsigned char* WT, LAS float* scr, int item, int lane, float scale) {
    const int nblk = N / 32, kb = item / nblk, nb = item % nblk, k0 = 64 * kb, n0 = 32 * nb;
    float tv[32];
#pragma unroll
    for (int i = 0; i < 32; ++i) { const int kk = 2 * i + (lane >> 5); tv[i] = __builtin_nontemporal_load((const GAS float*)(W + (size_t)(k0 + kk) * N + n0 + (lane & 31))); }
#pragma unroll
    for (int i = 0; i < 32; ++i) { const int kk = 2 * i + (lane >> 5); scr[kk * 33 + (lane & 31)] = tv[i] * scale; }
    LDS_WAIT(); asm volatile("" ::: "memory");
    const int c = lane & 3;
#pragma unroll
    for (int j = 0; j < 2; ++j) { const int n = (lane >> 2) + 16 * j; const LAS float* s = scr + (16 * c) * 33 + n;
        u32x4 o; o.x = pk4_fp8(s[0 * 33], s[1 * 33], s[2 * 33], s[3 * 33]); o.y = pk4_fp8(s[4 * 33], s[5 * 33], s[6 * 33], s[7 * 33]);
        o.z = pk4_fp8(s[8 * 33], s[9 * 33], s[10 * 33], s[11 * 33]); o.w = pk4_fp8(s[12 * 33], s[13 * 33], s[14 * 33], s[15 * 33]);
        *(GAS u32x4*)(WT + (size_t)dest_row<MAP>(n0 + n) * K + k0 + 16 * c) = o; }
    LDS_WAIT(); asm volatile("" ::: "memory");
}
__constant__ double ROPE_INV_FREQ[32] = {1.00000000000000000e+00, 7.49894209332455874e-01, 5.62341325190349073e-01, 4.21696503428582226e-01, 3.16227766016837941e-01, 2.37137370566165517e-01, 1.77827941003892293e-01, 1.33352143216332403e-01, 1.00000000000000006e-01, 7.49894209332455791e-02, 5.62341325190349114e-02, 4.21696503428582239e-02, 3.16227766016837913e-02, 2.37137370566165538e-02, 1.77827941003892293e-02, 1.33352143216332406e-02, 1.00000000000000002e-02, 7.49894209332455791e-03, 5.62341325190349097e-03, 4.21696503428582292e-03, 3.16227766016837939e-03, 2.37137370566165538e-03, 1.77827941003892275e-03, 1.33352143216332406e-03, 1.00000000000000002e-03, 7.49894209332455856e-04, 5.62341325190349097e-04, 4.21696503428582237e-04, 3.16227766016837939e-04, 2.37137370566165538e-04, 1.77827941003892270e-04, 1.33352143216332395e-04};
__device__ __forceinline__ void p0_prologue(Frame& F) {
    LAS float* scr = (LAS float*)(F.lds + F.wave * 16384);
    const int gw = F.vcu * NWAVES + F.wave, NGW = F.G * NWAVES;
    bf16* Wein = (bf16*)(F.ws + WS_WEIN); bf16* Weout = (bf16*)(F.ws + WS_WEOUT); bf16* Wgu = (bf16*)(F.ws + WS_WGU); bf16* Wdn = (bf16*)(F.ws + WS_WDN);
    bf16* Woin = (bf16*)(F.ws + WS_WOIN); bf16* Woout = (bf16*)(F.ws + WS_WOOUT);
    constexpr int I_EIN = 16 * (EVEN_IN / 32), I_SQ = 16 * 32, I_G = 16 * (DFF / 32), I_DN = (DFF / 64) * 32, I_OIN = 16 * (ODD_IN / 32);
    constexpr int NITEMS = I_EIN + I_SQ + 2 * I_G + I_DN + I_OIN + I_SQ;
    for (int it = gw; it < NITEMS; it += NGW) {
        int r = it;
        if (r < I_EIN) { transpose_item<4>(F.even_w_in, D, EVEN_IN, Wein, scr, r, F.lane); continue; } r -= I_EIN;
        if (r < I_SQ) { transpose_item<4>(F.even_w_out, D, D, Weout, scr, r, F.lane); continue; } r -= I_SQ;
        if (r < I_G) { transpose_item<2>(F.ffn_wg, D, DFF, Wgu, scr, r, F.lane); continue; } r -= I_G;
        if (r < I_G) { transpose_item<3>(F.ffn_wu, D, DFF, Wgu, scr, r, F.lane); continue; } r -= I_G;
        if (r < I_DN) { transpose_item8<4>(F.ffn_wd, DFF, D, (unsigned char*)Wdn, scr, r, F.lane, W2_SCALE); continue; } r -= I_DN;
        if (r < I_OIN) {
            constexpr int I_A = 16 * (2304 / 32), I_C = 16 * (512 / 32);
            if (r < I_A) { transpose_item<4>(F.odd_w_in, D, 2304, Woin, scr, r, F.lane, ODD_IN); continue; } r -= I_A;
            if (r < I_C) { transpose_item<2>(F.odd_w_in + 2304, D, 512, Woin + (size_t)2304 * D, scr, r, F.lane, ODD_IN); continue; } r -= I_C;
            if (r < I_C) { transpose_item<3>(F.odd_w_in + 3328, D, 512, Woin + (size_t)2304 * D, scr, r, F.lane, ODD_IN); continue; } r -= I_C;
            transpose_item<4>(F.odd_w_in + 2816, D, 512, Woin + (size_t)3328 * D, scr, r, F.lane, ODD_IN); continue; }
        r -= I_OIN;
        transpose_item<4>(F.odd_w_out, D, D, Woout, scr, r, F.lane);
    }
    bf16* xb = (bf16*)(F.ws + WS_XB);
    {
        f32x4 na[4], nb[4];
#define X_LOAD(buf, mm) do { if ((mm) < T) { _Pragma("unroll") for (int j_ = 0; j_ < 4; ++j_) buf[j_] = __builtin_nontemporal_load((const GAS f32x4*)(F.x + (size_t)(mm) * D) + F.lane + 64 * j_); } } while (0)
#define X_ROW(buf, mm) do { f32x4 v[4]; _Pragma("unroll") for (int j = 0; j < 4; ++j) v[j] = buf[j]; \
            X_LOAD(buf, (mm) + 2 * NGW); \
            GAS u32x2* o = (GAS u32x2*)(xb + (size_t)(mm) * D) + F.lane; \
            _Pragma("unroll") for (int j = 0; j < 4; ++j) { u32x2 w; w.x = pk2(v[j].x, v[j].y); w.y = pk2(v[j].z, v[j].w); o[64 * j] = w; } } while (0)
        X_LOAD(na, gw); X_LOAD(nb, gw + NGW);
        for (int m = gw; m < T; m += 2 * NGW) {
            X_ROW(na, m);
            if (m + NGW < T) X_ROW(nb, m + NGW);
        }
#undef X_LOAD
#undef X_ROW
    }
    const int gt = F.vcu * (NWAVES * 64) + F.tid, NGT = F.G * NWAVES * 64;
    bf16* pwt = (bf16*)(F.ws + WS_POOLWT);
    for (int idx = gt; idx < 4 * 64 * 64; idx += NGT) { const int g = idx >> 12, dd = (idx >> 6) & 63, c = idx & 63; pwt[idx] = (bf16)f2bf(F.pool_w[(g * 64 + c) * 64 + dd]); }
}


__device__ __forceinline__ void ln_row(const bf16* zrow, const float* w, const float* b, bf16* ob, int lane, f32x4 (&y)[4]) {
    const GAS u32x2* xr = (const GAS u32x2*)zrow + lane;
    f32x4 v[4]; float s = 0.f;
#pragma unroll
    for (int j = 0; j < 4; ++j) { v[j] = bf_lo4(xr[64 * j]); s += (v[j].x + v[j].y) + (v[j].z + v[j].w); }
    const float mean = wave_sum(s) * (1.f / D); float s2 = 0.f;
#pragma unroll
    for (int j = 0; j < 4; ++j) { v[j] = v[j] - mean; s2 += (v[j].x * v[j].x + v[j].y * v[j].y) + (v[j].z * v[j].z + v[j].w * v[j].w); }
    const float rstd = 1.f / sqrtf(wave_sum(s2) * (1.f / D) + LN_EPS);
    GAS u32x2* o2 = (GAS u32x2*)ob + lane;
#pragma unroll
    for (int j = 0; j < 4; ++j) {
        const f32x4 ww = ((const GAS f32x4*)w)[lane + 64 * j], bb = ((const GAS f32x4*)b)[lane + 64 * j];
        y[j] = v[j] * rstd * ww + bb;
        if (ob) { u32x2 p; p.x = cvtpk(y[j].x, y[j].y); p.y = cvtpk(y[j].z, y[j].w); o2[64 * j] = p; }
    }
}
__device__ __forceinline__ void ln_phase(Frame& F, int lnidx) {
    const int gw = F.vcu * NWAVES + F.wave, NGW = F.G * NWAVES, lane = F.lane;
    bf16* xb = (bf16*)(F.ws + WS_XB);
    f32x4 lw[4], lb[4];
#pragma unroll
    for (int j = 0; j < 4; ++j) { lw[j] = ((const GAS f32x4*)(F.ln_w + lnidx * D))[lane + 64 * j]; lb[j] = ((const GAS f32x4*)(F.ln_b + lnidx * D))[lane + 64 * j]; }
    u32x2 ra[4], rb[4];
#define LN_LOAD(buf, mm) do { if ((mm) < T) { _Pragma("unroll") for (int j_ = 0; j_ < 4; ++j_) buf[j_] = __builtin_nontemporal_load((const GAS u32x2*)(xb + (size_t)(mm) * D) + lane + 64 * j_); } } while (0)
#define LN_ROW(buf, mm) do { f32x4 v[4]; float s = 0.f; \
        _Pragma("unroll") for (int j = 0; j < 4; ++j) { v[j] = bf_lo4(buf[j]); s += (v[j].x + v[j].y) + (v[j].z + v[j].w); } \
        LN_LOAD(buf, (mm) + 2 * NGW); \
        const float mean = wave_sum(s) * (1.f / D); float s2 = 0.f; \
        _Pragma("unroll") for (int j = 0; j < 4; ++j) { v[j] = v[j] - mean; s2 += (v[j].x * v[j].x + v[j].y * v[j].y) + (v[j].z * v[j].z + v[j].w * v[j].w); } \
        const float rstd = 1.f / sqrtf(wave_sum(s2) * (1.f / D) + LN_EPS); \
        _Pragma("unroll") for (int j = 0; j < 4; ++j) { const f32x4 y = v[j] * rstd * lw[j] + lb[j]; u32x2 p; p.x = cvtpk(y.x, y.y); p.y = cvtpk(y.z, y.w); ((GAS u32x2*)(xb + (size_t)(mm) * D))[lane + 64 * j] = p; } } while (0)
    LN_LOAD(ra, gw); LN_LOAD(rb, gw + NGW);
    for (int m = gw; m < T; m += 2 * NGW) {
        LN_ROW(ra, m);
        if (m + NGW < T) LN_ROW(rb, m + NGW);
    }
#undef LN_LOAD
#undef LN_ROW
}

constexpr int AT_KROW = 144;
constexpr int AT_VROW = 776;
constexpr int AT_K_OFF = 0, AT_V_OFF = 384 * AT_KROW;
static_assert(AT_V_OFF + 64 * AT_VROW <= RING_BYTES, "attention LDS");
__device__ __forceinline__ int crow(int reg, int h) { return (reg & 3) + 8 * (reg >> 2) + 4 * h; }
struct AttnUnit {
    const bf16* src; int ld;
    int rowbase, rstride, i0;
    int qcol0, nh, kcol, vcol;
    bf16* O; int ldo, ocol0;
    int o8 = 0;
    float* lse; int lse_h0;
    const float* sinks; int sink_h0;
    int maxdist;
    const int* pos;
};
__device__ __forceinline__ void rope_cs(float pf, float chi, float clo, float& c, float& sn) {
    const float rev = __builtin_amdgcn_fractf(pf * chi) + pf * clo;
    c = __builtin_amdgcn_cosf(rev); sn = __builtin_amdgcn_sinf(rev);
}
typedef _Float16 half2_t __attribute__((ext_vector_type(2)));
__device__ __forceinline__ float h_lo(unsigned w) { return (float)__builtin_bit_cast(half2_t, w).x; }
__device__ __forceinline__ float h_hi(unsigned w) { return (float)__builtin_bit_cast(half2_t, w).y; }
__device__ __forceinline__ void rope_q(const u32x4 (&qraw)[4], const float (&rc)[2][8], const float (&rs)[2][8], bf16x8 (&qf)[4]) {
#pragma unroll
    for (int a = 0; a < 2; ++a) {
        u32x4 w1, w2;
#pragma unroll
        for (int q = 0; q < 4; ++q) {
            const float ca = rc[a][2 * q], cb = rc[a][2 * q + 1], sa = rs[a][2 * q], sb = rs[a][2 * q + 1];
            const float x1a = __uint_as_float(qraw[a][q] << 16), x1b = __uint_as_float(qraw[a][q] & 0xffff0000u), x2a = __uint_as_float(qraw[a + 2][q] << 16), x2b = __uint_as_float(qraw[a + 2][q] & 0xffff0000u);
            w1[q] = cvtpk(x1a * ca - x2a * sa, x1b * cb - x2b * sb); w2[q] = cvtpk(x2a * ca + x1a * sa, x2b * cb + x1b * sb);
        }
        qf[a] = __builtin_bit_cast(bf16x8, w1); qf[a + 2] = __builtin_bit_cast(bf16x8, w2);
    }
}
template <int V> struct IC { static constexpr int value = V; };
template <int NHH>
__device__ __forceinline__ void attn_heads(const AttnUnit& U, int hh0, const bf16x8 (*qf)[4], LAS unsigned char* ldsK, LAS unsigned char* ldsV,
                                           int qt, int iq, size_t qrow, int r32, int hi) {
    float m[NHH], l[NHH]; f32x16 o0[NHH], o1[NHH];
#pragma unroll
    for (int h = 0; h < NHH; ++h) {
        if (U.sinks) { m[h] = U.sinks[U.sink_h0 + hh0 + h] * LOG2E; l[h] = (hi == 0) ? 1.f : 0.f; } else { m[h] = -1e30f; l[h] = 0.f; }
#pragma unroll
        for (int i = 0; i < 16; ++i) { o0[h][i] = 0.f; o1[h][i] = 0.f; }
    }
    auto tile = [&](const int kt, auto mode_) {
        constexpr int MODE = decltype(mode_)::value;
        const int ktl = qt + kt, j0 = U.i0 - 128 + 32 * ktl;
        if (j0 < 0) return;
        bf16x8 kf[4];
#pragma unroll
        for (int d0 = 0; d0 < 4; ++d0) kf[d0] = *(const LAS bf16x8*)(ldsK + (32 * ktl + r32) * AT_KROW + d0 * 32 + hi * 16);
        f32x16 s[NHH];
#pragma unroll
        for (int h = 0; h < NHH; ++h) {
#pragma unroll
            for (int i = 0; i < 16; ++i) s[h][i] = 0.f;
        }
#pragma unroll
        for (int d0 = 0; d0 < 4; ++d0)
#pragma unroll
            for (int h = 0; h < NHH; ++h) s[h] = __builtin_amdgcn_mfma_f32_32x32x16_bf16(kf[d0], qf[h][d0], s[h], 0, 0, 0);
        if constexpr (MODE != 0) {
            const int dq = iq - j0 - 4 * hi, bb = (kt == 0) ? dq - U.maxdist : -dq, sg = (kt == 0) ? 1 : -1;
#pragma unroll
            for (int i = 0; i < 16; ++i) { const int ci = ((i & 3) + 8 * (i >> 2)) * sg; const bool ok = bb <= ci;
#pragma unroll
                for (int h = 0; h < NHH; ++h) s[h][i] = ok ? s[h][i] : -INFINITY; }
        }
        u32x4 pw[NHH][2];
#pragma unroll
        for (int h = 0; h < NHH; ++h) {
            float mt = s[h][0];
#pragma unroll
            for (int i = 1; i < 16; ++i) mt = fmaxf(mt, s[h][i]);
            { const auto rr = __builtin_amdgcn_permlane32_swap(__float_as_uint(mt), __float_as_uint(mt), false, false); mt = fmaxf(__uint_as_float(rr[0]), __uint_as_float(rr[1])); }
            if (__any(mt > m[h] + 8.0f)) {
                const float mn = fmaxf(m[h], mt), alpha = __builtin_amdgcn_exp2f(m[h] - mn); m[h] = mn; l[h] *= alpha;
#pragma unroll
                for (int i = 0; i < 16; ++i) { o0[h][i] *= alpha; o1[h][i] *= alpha; }
            }
            float ps = 0.f;
#pragma unroll
            for (int i = 0; i < 16; ++i) { s[h][i] = __builtin_amdgcn_exp2f(s[h][i] - m[h]); ps += s[h][i]; }
            l[h] += ps;
#pragma unroll
            for (int s2 = 0; s2 < 2; ++s2) { pw[h][s2].x = cvtpk(s[h][8 * s2 + 0], s[h][8 * s2 + 1]); pw[h][s2].y = cvtpk(s[h][8 * s2 + 2], s[h][8 * s2 + 3]); pw[h][s2].z = cvtpk(s[h][8 * s2 + 4], s[h][8 * s2 + 5]); pw[h][s2].w = cvtpk(s[h][8 * s2 + 6], s[h][8 * s2 + 7]); }
        }
#pragma unroll
        for (int s2 = 0; s2 < 2; ++s2) {
            const int kb = (32 * ktl + 16 * s2 + 4 * hi) * 2;
            { const u32x2 lo = *(const LAS u32x2*)(ldsV + r32 * AT_VROW + kb), hi8 = *(const LAS u32x2*)(ldsV + r32 * AT_VROW + kb + 16);
              u32x4 vv; vv.x = lo.x; vv.y = lo.y; vv.z = hi8.x; vv.w = hi8.y;
#pragma unroll
              for (int h = 0; h < NHH; ++h) o0[h] = __builtin_amdgcn_mfma_f32_32x32x16_bf16(__builtin_bit_cast(bf16x8, vv), __builtin_bit_cast(bf16x8, pw[h][s2]), o0[h], 0, 0, 0); }
            { const u32x2 lo = *(const LAS u32x2*)(ldsV + (32 + r32) * AT_VROW + kb), hi8 = *(const LAS u32x2*)(ldsV + (32 + r32) * AT_VROW + kb + 16);
              u32x4 vv; vv.x = lo.x; vv.y = lo.y; vv.z = hi8.x; vv.w = hi8.y;
#pragma unroll
              for (int h = 0; h < NHH; ++h) o1[h] = __builtin_amdgcn_mfma_f32_32x32x16_bf16(__builtin_bit_cast(bf16x8, vv), __builtin_bit_cast(bf16x8, pw[h][s2]), o1[h], 0, 0, 0); }
        }
    };
#pragma unroll 1
    for (int kt = 1; kt < 4; ++kt) tile(kt, IC<0>{});
#pragma unroll 1
    for (int kt = 0; kt < 5; kt += 4) tile(kt, IC<1>{});
#pragma unroll
    for (int h = 0; h < NHH; ++h) {
        float lt = l[h];
        { const auto rr = __builtin_amdgcn_permlane32_swap(__float_as_uint(lt), __float_as_uint(lt), false, false); lt = __uint_as_float(rr[0]) + __uint_as_float(rr[1]); }
        const float inv = __builtin_amdgcn_rcpf(lt);
        if (U.o8) {
            const float i8 = inv * OG_SCALE; unsigned char* op8 = (unsigned char*)U.O + qrow * U.ldo + U.ocol0 + 64 * (hh0 + h);
#pragma unroll
            for (int g4 = 0; g4 < 4; ++g4) {
                *(GAS unsigned*)(op8 + 8 * g4 + 4 * hi) = pk4_fp8(o0[h][4 * g4] * i8, o0[h][4 * g4 + 1] * i8, o0[h][4 * g4 + 2] * i8, o0[h][4 * g4 + 3] * i8);
                *(GAS unsigned*)(op8 + 32 + 8 * g4 + 4 * hi) = pk4_fp8(o1[h][4 * g4] * i8, o1[h][4 * g4 + 1] * i8, o1[h][4 * g4 + 2] * i8, o1[h][4 * g4 + 3] * i8);
            }
        } else {
        bf16* op = U.O + qrow * U.ldo + U.ocol0 + 64 * (hh0 + h);
#pragma unroll
        for (int g4 = 0; g4 < 4; ++g4) {
            u32x2 w; w.x = cvtpk(o0[h][4 * g4] * inv, o0[h][4 * g4 + 1] * inv); w.y = cvtpk(o0[h][4 * g4 + 2] * inv, o0[h][4 * g4 + 3] * inv); *(GAS u32x2*)(op + 8 * g4 + 4 * hi) = w;
            u32x2 w2; w2.x = cvtpk(o1[h][4 * g4] * inv, o1[h][4 * g4 + 1] * inv); w2.y = cvtpk(o1[h][4 * g4 + 2] * inv, o1[h][4 * g4 + 3] * inv); *(GAS u32x2*)(op + 32 + 8 * g4 + 4 * hi) = w2;
        }
        }
        if (U.lse && hi == 0) U.lse[qrow * 8 + U.lse_h0 + hh0 + h] = m[h] + __builtin_amdgcn_logf(lt);
    }
}
template <int NH> __device__ __forceinline__ void attn_unit(Frame& F, const AttnUnit& U) {
    LAS unsigned char* ldsK = F.lds + AT_K_OFF; LAS unsigned char* ldsV = F.lds + AT_V_OFF;
    int tid = F.tid; asm volatile("" : "+v"(tid));
    const int lane = tid & 63, r32 = lane & 31, hi = lane >> 5, wid = F.wave;
    u32x4 kv1[3], kv2[3], vv0[3], vv1[3]; int kp[3];
#pragma unroll
    for (int it = 0; it < 3; ++it) {
        const int idx = tid + it * (NWAVES * 64), kk = idx >> 2, ch = idx & 3, j = U.i0 - 128 + kk, jc = j < 0 ? 0 : j;
        const size_t tok = (size_t)(U.rowbase + jc * U.rstride);
        kv1[it] = *(const GAS u32x4*)(U.src + tok * U.ld + U.kcol + ch * 8); kv2[it] = *(const GAS u32x4*)(U.src + tok * U.ld + U.kcol + 32 + ch * 8);
        kp[it] = U.pos[tok];
    }
#pragma unroll
    for (int it = 0; it < 3; ++it) {
        const int idx = tid + it * (NWAVES * 64), p = idx % 192, ch = idx / 192, j = U.i0 - 128 + 2 * p, jc = j < 0 ? 0 : j;
        vv0[it] = *(const GAS u32x4*)(U.src + (size_t)(U.rowbase + jc * U.rstride) * U.ld + U.vcol + ch * 8);
        vv1[it] = *(const GAS u32x4*)(U.src + (size_t)(U.rowbase + (jc + 1) * U.rstride) * U.ld + U.vcol + ch * 8);
    }
    const int qt = wid;
    const int iq = U.i0 + 32 * qt + r32;
    const size_t qrow = (size_t)(U.rowbase + iq * U.rstride);
    u32x4 qraw[NH][4]; const int qpos = U.pos[qrow];
#pragma unroll
    for (int h = 0; h < NH; ++h)
#pragma unroll
        for (int d0 = 0; d0 < 4; ++d0) qraw[h][d0] = *(const GAS u32x4*)(U.src + qrow * U.ld + U.qcol0 + 64 * h + 16 * d0 + 8 * hi);
    const LAS float* rcst = (const LAS float*)(F.lds + ROPEC_OFF);
    f32x4 khi[2], klo[2];
#pragma unroll
    for (int h2 = 0; h2 < 2; ++h2) { khi[h2] = *(const LAS f32x4*)(rcst + 8 * (tid & 3) + 4 * h2); klo[h2] = *(const LAS f32x4*)(rcst + 32 + 8 * (tid & 3) + 4 * h2); }
#pragma unroll
    for (int it = 0; it < 3; ++it) {
        const int idx = tid + it * (NWAVES * 64), kk = idx >> 2, ch = idx & 3;
        const u32x4 v1 = kv1[it], v2 = kv2[it]; const float pf = (float)kp[it];
        u32x4 w1, w2;
#pragma unroll
        for (int q = 0; q < 4; ++q) {
            float ca, cb, sa, sb; rope_cs(pf, khi[q >> 1][2 * (q & 1)], klo[q >> 1][2 * (q & 1)], ca, sa); rope_cs(pf, khi[q >> 1][2 * (q & 1) + 1], klo[q >> 1][2 * (q & 1) + 1], cb, sb);
            const float x1a = __uint_as_float(v1[q] << 16), x1b = __uint_as_float(v1[q] & 0xffff0000u), x2a = __uint_as_float(v2[q] << 16), x2b = __uint_as_float(v2[q] & 0xffff0000u);
            w1[q] = cvtpk(x1a * ca - x2a * sa, x1b * cb - x2b * sb); w2[q] = cvtpk(x2a * ca + x1a * sa, x2b * cb + x1b * sb);
        }
        *(LAS u32x4*)(ldsK + kk * AT_KROW + ch * 16) = w1; *(LAS u32x4*)(ldsK + kk * AT_KROW + 64 + ch * 16) = w2;
    }
#pragma unroll
    for (int it = 0; it < 3; ++it) {
        const int idx = tid + it * (NWAVES * 64), p = idx % 192, ch = idx / 192, kk = 2 * p;
#pragma unroll
        for (int q = 0; q < 4; ++q) {
            const unsigned a = vv0[it][q], b2 = vv1[it][q];
            *(LAS unsigned*)(ldsV + (ch * 8 + 2 * q) * AT_VROW + kk * 2) = (a & 0xffffu) | (b2 << 16);
            *(LAS unsigned*)(ldsV + (ch * 8 + 2 * q + 1) * AT_VROW + kk * 2) = (a >> 16) | (b2 & 0xffff0000u);
        }
    }
    __syncthreads();
    bf16x8 qf[NH][4];
    {
        float rc[2][8], rs[2][8]; const float qpf = (float)qpos;
#pragma unroll
        for (int a = 0; a < 2; ++a)
#pragma unroll
            for (int j = 0; j < 8; ++j) { float c, sn; rope_cs(qpf, rcst[16 * a + 8 * hi + j], rcst[32 + 16 * a + 8 * hi + j], c, sn); rc[a][j] = c * C2; rs[a][j] = sn * C2; }
#pragma unroll
        for (int h = 0; h < NH; ++h) rope_q(qraw[h], rc, rs, qf[h]);
    }
    if (wid >= 4) __builtin_amdgcn_s_setprio(1);
    attn_heads<2>(U, 0, &qf[0], ldsK, ldsV, qt, iq, qrow, r32, hi);
    attn_heads<NH - 2>(U, 2, &qf[2], ldsK, ldsV, qt, iq, qrow, r32, hi);
    if (wid >= 4) __builtin_amdgcn_s_setprio(0);
    __syncthreads();
}

constexpr int PL_ROW = 528;
__device__ __forceinline__ void pool_unit(Frame& F, int unit) {
    const int b = unit >> 5, t0 = (unit & 31) * 128;
    const bf16* h0 = (const bf16*)(F.ws + WS_H0); bf16* m0 = (bf16*)(F.ws + WS_M0); const bf16* pwt = (const bf16*)(F.ws + WS_POOLWT);
    const int tid = F.tid, lane = F.lane, r32 = lane & 31, hi = lane >> 5, wid = F.wave;
    for (int idx = tid; idx < 143 * 32; idx += NWAVES * 64) {
        const int lr = idx >> 5, ch = idx & 31, s = t0 - 15 + lr;
        u32x4 v = {0u, 0u, 0u, 0u};
        if (s >= 0) v = *(const GAS u32x4*)(h0 + (size_t)(b * SEQ + s) * EVEN_IN + ch * 8);
        *(LAS u32x4*)(F.lds + lr * PL_ROW + ch * 16) = v;
    }
    __syncthreads();
    const int tt = wid & 3, gp = wid >> 2;
    const int lr = 15 + 32 * tt + r32, spos = t0 + 32 * tt + r32;
    const size_t orow = (size_t)(b * SEQ + spos);
#pragma unroll
    for (int gg = 0; gg < 2; ++gg) {
        const int gi = 2 * gp + gg, wd = 2 << gi;
        const float rc = 1.0f / (float)((spos + 1) < wd ? (spos + 1) : wd);
        bf16x8 df[4];
#pragma unroll
        for (int ks = 0; ks < 4; ++ks) {
            const int cb = (64 * gi + 16 * ks + 8 * hi) * 2;
            float sum[8];
#pragma unroll
            for (int e = 0; e < 8; ++e) sum[e] = 0.f;
            for (int k = 0; k < wd; ++k) { const u32x4 v = *(const LAS u32x4*)(F.lds + (lr - k) * PL_ROW + cb);
#pragma unroll
                for (int q = 0; q < 4; ++q) { sum[2 * q] += __uint_as_float(v[q] << 16); sum[2 * q + 1] += __uint_as_float(v[q] & 0xffff0000u); } }
            const u32x4 v = *(const LAS u32x4*)(F.lds + lr * PL_ROW + cb);
            u32x4 pw;
#pragma unroll
            for (int q = 0; q < 4; ++q) { const float d0 = sum[2 * q] * rc - __uint_as_float(v[q] << 16), d1 = sum[2 * q + 1] * rc - __uint_as_float(v[q] & 0xffff0000u); pw[q] = cvtpk(d0, d1); }
            df[ks] = __builtin_bit_cast(bf16x8, pw);
        }
#pragma unroll
        for (int nt = 0; nt < 2; ++nt) {
            f32x16 acc;
#pragma unroll
            for (int i = 0; i < 16; ++i) acc[i] = 0.f;
#pragma unroll
            for (int ks = 0; ks < 4; ++ks) { const bf16x8 wf = *(const GAS bf16x8*)(pwt + (size_t)(gi * 64 + 32 * nt + r32) * 64 + 16 * ks + 8 * hi); acc = __builtin_amdgcn_mfma_f32_32x32x16_bf16(wf, df[ks], acc, 0, 0, 0); }
#pragma unroll
            for (int g4 = 0; g4 < 4; ++g4) {
                const int dd = 64 * gi + 32 * nt + 8 * g4 + 4 * hi;
                const f32x4 sc = *(const GAS f32x4*)(F.pool_scale + dd);
                u32x2 w; w.x = cvtpk(acc[4 * g4] * sc[0], acc[4 * g4 + 1] * sc[1]); w.y = cvtpk(acc[4 * g4 + 2] * sc[2], acc[4 * g4 + 3] * sc[3]);
                *(GAS u32x2*)(m0 + orow * D + dd) = w;
            }
        }
    }
    __syncthreads();
}

__device__ __forceinline__ f32x4 fp8x4(unsigned w) { return (f32x4){__builtin_amdgcn_cvt_f32_fp8((int)w, 0), __builtin_amdgcn_cvt_f32_fp8((int)w, 1), __builtin_amdgcn_cvt_f32_fp8((int)w, 2), __builtin_amdgcn_cvt_f32_fp8((int)w, 3)}; }
__device__ __forceinline__ void merge_phase(Frame& F) {
    const int gw = F.vcu * NWAVES + F.wave, NGW = F.G * NWAVES, lane = F.lane;
    const unsigned char* og = F.ws + WS_OG; const float* lse = (const float*)(F.ws + WS_LSE); bf16* m1 = (bf16*)(F.ws + WS_M1);
    const int head = lane >> 3;
    float la[3], lb_[3]; u32x2 aa[3], ab[3];
#define MC_LOAD(lbuf, abuf, tk) do { if ((tk) < T) { \
        _Pragma("unroll") for (int g_ = 0; g_ < 3; ++g_) { lbuf[g_] = __builtin_nontemporal_load((const GAS float*)(lse + ((size_t)g_ * T + (tk)) * 8 + head)); abuf[g_] = __builtin_nontemporal_load((const GAS u32x2*)(og + ((size_t)g_ * T + (tk)) * 512 + 8 * lane)); } } } while (0)
#define MC_TOK(lbuf, abuf, tok) do { float l[3]; u32x2 a[3]; \
        _Pragma("unroll") for (int g = 0; g < 3; ++g) { l[g] = lbuf[g]; a[g] = abuf[g]; } \
        MC_LOAD(lbuf, abuf, (tok) + 2 * NGW); \
        const float mx = fmaxf(l[0], fmaxf(l[1], l[2])); \
        float w0 = __builtin_amdgcn_exp2f(l[0] - mx), w1 = __builtin_amdgcn_exp2f(l[1] - mx), w2 = __builtin_amdgcn_exp2f(l[2] - mx); \
        const float ws_ = (1.0f / OG_SCALE) / (w0 + w1 + w2); w0 *= ws_; w1 *= ws_; w2 *= ws_; \
        float mo[8]; \
        _Pragma("unroll") for (int q = 0; q < 2; ++q) { const f32x4 v_ = fp8x4(a[0][q]) * w0 + fp8x4(a[1][q]) * w1 + fp8x4(a[2][q]) * w2; mo[4 * q] = v_[0]; mo[4 * q + 1] = v_[1]; mo[4 * q + 2] = v_[2]; mo[4 * q + 3] = v_[3]; } \
        u32x4 co; co.x = cvtpk(mo[0], mo[1]); co.y = cvtpk(mo[2], mo[3]); co.z = cvtpk(mo[4], mo[5]); co.w = cvtpk(mo[6], mo[7]); \
        *(GAS u32x4*)(m1 + (size_t)(tok) * D + 8 * lane) = co; } while (0)
    MC_LOAD(la, aa, gw); MC_LOAD(lb_, ab, gw + NGW);
    for (int tok = gw; tok < T; tok += 2 * NGW) {
        MC_TOK(la, aa, tok);
        if (tok + NGW < T) MC_TOK(lb_, ab, tok + NGW);
    }
#undef MC_LOAD
#undef MC_TOK
}

__device__ __forceinline__ void conv_chunk(Frame& F, int chunk) {
    const int lane = F.lane, t0 = chunk * 128 + F.wave * 16;
    const bf16* h1 = (const bf16*)(F.ws + WS_H1) + 2304 + 8 * lane; bf16* m1 = (bf16*)(F.ws + WS_M1) + 512 + 8 * lane;
    float cw[3][8];
#pragma unroll
    for (int k = 0; k < 3; ++k)
#pragma unroll
        for (int e = 0; e < 8; ++e) cw[k][e] = F.conv_w[k * 512 + 8 * lane + e];
    float z1[8], z2[8];
#pragma unroll
    for (int e = 0; e < 8; ++e) { z1[e] = 0.f; z2[e] = 0.f; }
    if ((t0 & (SEQ - 1)) != 0) {
        const u32x4 h_1 = *(const GAS u32x4*)(h1 + (size_t)(t0 - 1) * ODD_IN), h_2 = *(const GAS u32x4*)(h1 + (size_t)(t0 - 2) * ODD_IN);
#pragma unroll
        for (int q = 0; q < 4; ++q) {
            z1[2 * q] = __uint_as_float(h_1[q] << 16); z1[2 * q + 1] = __uint_as_float(h_1[q] & 0xffff0000u);
            z2[2 * q] = __uint_as_float(h_2[q] << 16); z2[2 * q + 1] = __uint_as_float(h_2[q] & 0xffff0000u);
        }
    }
    u32x4 hn[2], bn[2];
#define CV_LOAD(s_, tk) do { const bf16* r_ = h1 + (size_t)(tk) * ODD_IN; hn[s_] = *(const GAS u32x4*)r_; bn[s_] = *(const GAS u32x4*)(r_ + 512); } while (0)
    CV_LOAD(0, t0); CV_LOAD(1, t0 + 1);
#pragma unroll
    for (int i = 0; i < 16; ++i) {
        const u32x4 hd = hn[i & 1], gb = bn[i & 1];
        if (i + 2 < 16) CV_LOAD(i & 1, t0 + i + 2);
        float z0[8], y[8];
#pragma unroll
        for (int q = 0; q < 4; ++q) { z0[2 * q] = __uint_as_float(hd[q] << 16); z0[2 * q + 1] = __uint_as_float(hd[q] & 0xffff0000u); }
#pragma unroll
        for (int e = 0; e < 8; ++e) { y[e] = cw[0][e] * z2[e] + cw[1][e] * z1[e] + cw[2][e] * z0[e]; z2[e] = z1[e]; z1[e] = z0[e]; }
#pragma unroll
        for (int q = 0; q < 4; ++q) { y[2 * q] *= __uint_as_float(gb[q] << 16); y[2 * q + 1] *= __uint_as_float(gb[q] & 0xffff0000u); }
        u32x4 dv; dv.x = cvtpk(y[0], y[1]); dv.y = cvtpk(y[2], y[3]); dv.z = cvtpk(y[4], y[5]); dv.w = cvtpk(y[6], y[7]);
        *(GAS u32x4*)(m1 + (size_t)(t0 + i) * D) = dv;
    }
#undef CV_LOAD
}

__device__ __forceinline__ void router_phase(Frame& F) {
    const int gw = F.vcu * NWAVES + F.wave, NGW = F.G * NWAVES, lane = F.lane, tid = F.tid;
    LAS float* rw = (LAS float*)F.lds;
    LAS int* rinfo = (LAS int*)(F.lds + 32768);
    LAS int* lcnt = (LAS int*)(F.lds + 32768 + 8 * 32 * 6 * 4);
    for (int i = tid; i < D * NE / 4; i += NWAVES * 64) ((LAS f32x4*)rw)[i] = ((const GAS f32x4*)F.router_w)[i];
    if (tid < 16) lcnt[tid] = 0;
    __syncthreads();
    unsigned char* x8 = (unsigned char*)F.res + DO_X8; bf16* xb = (bf16*)(F.ws + WS_XB);
    f32x4 lw[4], lb[4];
#pragma unroll
    for (int j = 0; j < 4; ++j) { lw[j] = ((const GAS f32x4*)(F.ln_w + 2 * D))[lane + 64 * j]; lb[j] = ((const GAS f32x4*)(F.ln_b + 2 * D))[lane + 64 * j]; }
    u32x2 rawn[4];
    if (gw < T) {
#pragma unroll
        for (int j = 0; j < 4; ++j) rawn[j] = __builtin_nontemporal_load((const GAS u32x2*)(xb + (size_t)gw * D) + lane + 64 * j); }
    int k = 0;
    for (int m = gw; m < T; m += NGW, ++k) {
        f32x4 v[4], y[4]; float s = 0.f;
#pragma unroll
        for (int j = 0; j < 4; ++j) { v[j] = bf_lo4(rawn[j]); s += (v[j].x + v[j].y) + (v[j].z + v[j].w); }
        if (m + NGW < T) {
#pragma unroll
            for (int j = 0; j < 4; ++j) rawn[j] = __builtin_nontemporal_load((const GAS u32x2*)(xb + (size_t)(m + NGW) * D) + lane + 64 * j); }
        const float mean = wave_sum(s) * (1.f / D); float s2 = 0.f;
#pragma unroll
        for (int j = 0; j < 4; ++j) { v[j] = v[j] - mean; s2 += (v[j].x * v[j].x + v[j].y * v[j].y) + (v[j].z * v[j].z + v[j].w * v[j].w); }
        const float rstd = 1.f / sqrtf(wave_sum(s2) * (1.f / D) + LN_EPS);
#pragma unroll
        for (int j = 0; j < 4; ++j) {
            y[j] = v[j] * rstd * lw[j] + lb[j];
            ((GAS unsigned*)(x8 + (size_t)m * D))[lane + 64 * j] = pk4_fp8(y[j].x, y[j].y, y[j].z, y[j].w);
        }
        float lg[8];
#pragma unroll
        for (int e = 0; e < 8; ++e) lg[e] = 0.f;
#pragma unroll
        for (int j = 0; j < 4; ++j)
#pragma unroll
            for (int q = 0; q < 4; ++q) { const int c = 4 * lane + 256 * j + q; const f32x4 wa = *(const LAS f32x4*)(rw + c * 8), wb = *(const LAS f32x4*)(rw + c * 8 + 4); const float xv = y[j][q];
                lg[0] += xv * wa[0]; lg[1] += xv * wa[1]; lg[2] += xv * wa[2]; lg[3] += xv * wa[3]; lg[4] += xv * wb[0]; lg[5] += xv * wb[1]; lg[6] += xv * wb[2]; lg[7] += xv * wb[3]; }
        float r4[4], r2[2], r1;
#pragma unroll
        for (int i = 0; i < 4; ++i) { const float snd = (lane & 32) ? lg[i] : lg[i + 4], kp = (lane & 32) ? lg[i + 4] : lg[i]; r4[i] = kp + __shfl_xor(snd, 32); }
#pragma unroll
        for (int i = 0; i < 2; ++i) { const float snd = (lane & 16) ? r4[i] : r4[i + 2], kp = (lane & 16) ? r4[i + 2] : r4[i]; r2[i] = kp + __shfl_xor(snd, 16); }
        { const float snd = (lane & 8) ? r2[0] : r2[1], kp = (lane & 8) ? r2[1] : r2[0]; r1 = kp + __shfl_xor(snd, 8); }
        r1 += __shfl_xor(r1, 4); r1 += __shfl_xor(r1, 2); r1 += __shfl_xor(r1, 1);
        float lgt[8];
#pragma unroll
        for (int e = 0; e < 8; ++e) lgt[e] = __uint_as_float(__builtin_amdgcn_readlane(__float_as_uint(r1), 8 * e));
        {
            int e0 = 0; float b0 = lgt[0];
#pragma unroll
            for (int e = 1; e < 8; ++e) if (lgt[e] > b0) { b0 = lgt[e]; e0 = e; }
            int e1 = -1; float b1 = -INFINITY;
#pragma unroll
            for (int e = 0; e < 8; ++e) if (e != e0 && lgt[e] > b1) { b1 = lgt[e]; e1 = e; }
            const float g1 = 1.0f / (1.0f + __expf(b0 - b1)), g0 = 1.0f - g1;
            if (lane == 0) {
                const int ls0 = atomicAdd((int*)&lcnt[e0], 1), ls1 = atomicAdd((int*)&lcnt[e1], 1);
                LAS int* ri = rinfo + (F.wave * 32 + k) * 6;
                ri[0] = e0; ri[1] = e1; ri[2] = __float_as_int(g0); ri[3] = __float_as_int(g1); ri[4] = ls0; ri[5] = ls1;
            }
        }
    }
    __syncthreads();
    if (tid < 8) lcnt[8 + tid] = (int)__hip_atomic_fetch_add(F.ctl + CW_CNT + 64 * tid, (unsigned)lcnt[tid], RLX_AGENT);
    __syncthreads();
    int* list = (int*)(F.ws + WS_LIST); int* tinfo = (int*)(F.ws + WS_TOKINFO);
    for (int kk = lane; kk < 32; kk += 64) {
        const int m = gw + kk * NGW;
        if (m < T) {
            const LAS int* ri = rinfo + (F.wave * 32 + kk) * 6;
            const int e0 = ri[0], e1 = ri[1], s0 = lcnt[8 + e0] + ri[4], s1 = lcnt[8 + e1] + ri[5];
            list[(size_t)e0 * T + s0] = m; list[(size_t)e1 * T + s1] = m;
            int* ti = tinfo + (size_t)m * 6; ti[0] = e0; ti[1] = s0; ti[2] = ri[2]; ti[3] = e1; ti[4] = s1; ti[5] = ri[3];
        }
    }
    __syncthreads();
    LAS float* scr = (LAS float*)(F.lds + F.wave * 16384);
    constexpr int I_G = 16 * (DFFE / 32), I_D = (DFFE / 64) * 32, I_E = 2 * I_G + I_D;
    const float* cwg = F.moe_wg; const float* cwu = F.moe_wu; const float* cwd = F.moe_wd; asm volatile("" : "+s"(cwg), "+s"(cwu), "+s"(cwd));
#define CONV_DESC(it_, W_, WT_, K_, N_, k0_, n0_, map_, sc_) do { const int e_ = (it_) / I_E; int r_ = (it_) % I_E; \
        if (r_ < 2 * I_G) { const int up_ = r_ >= I_G; r_ -= up_ * I_G; W_ = (up_ ? cwu : cwg) + (size_t)e_ * D * DFFE; K_ = D; N_ = DFFE; WT_ = (unsigned char*)F.res + DO_WM8 + (size_t)e_ * 2 * DFFE * D; map_ = 2 + up_; sc_ = up_ ? W1_SCALE : W1_SCALE * LOG2E; } \
        else { r_ -= 2 * I_G; W_ = cwd + (size_t)e_ * DFFE * D; K_ = DFFE; N_ = D; WT_ = (unsigned char*)F.res + DO_WMD8 + (size_t)e_ * D * DFFE; map_ = 4; sc_ = W2_SCALE; } \
        const int nblk_ = N_ / 32; k0_ = 64 * (r_ / nblk_); n0_ = 32 * (r_ % nblk_); } while (0)
    {
        float tvn[32]; const float* nW; unsigned char* nWT; int nK, nN, nk0, nn0, nmap; float nsc;
        CONV_DESC((gw < NE * I_E ? gw : 0), nW, nWT, nK, nN, nk0, nn0, nmap, nsc);
#pragma unroll
        for (int i = 0; i < 32; ++i) { const int kk = 2 * i + (lane >> 5); tvn[i] = __builtin_nontemporal_load((const GAS float*)(nW + (size_t)(nk0 + kk) * nN + nn0 + (lane & 31))); }
        for (int it = gw; it < NE * I_E; it += NGW) {
            unsigned char* const cWT = nWT; const int cK = nK, ck0 = nk0, cn0 = nn0, cmap = nmap; const float csc = nsc; float tv[32];
#pragma unroll
            for (int i = 0; i < 32; ++i) tv[i] = tvn[i];
            if (it + NGW < NE * I_E) { CONV_DESC(it + NGW, nW, nWT, nK, nN, nk0, nn0, nmap, nsc);
#pragma unroll
                for (int i = 0; i < 32; ++i) { const int kk = 2 * i + (lane >> 5); tvn[i] = __builtin_nontemporal_load((const GAS float*)(nW + (size_t)(nk0 + kk) * nN + nn0 + (lane & 31))); } }
#pragma unroll
            for (int i = 0; i < 32; ++i) { const int kk = 2 * i + (lane >> 5); scr[kk * 33 + (lane & 31)] = tv[i] * csc; }
            LDS_WAIT(); asm volatile("" ::: "memory");
            const int c = lane & 3;
#pragma unroll
            for (int j = 0; j < 2; ++j) { const int n = (lane >> 2) + 16 * j; const LAS float* sp = scr + (16 * c) * 33 + n;
                u32x4 o; o.x = pk4_fp8(sp[0 * 33], sp[1 * 33], sp[2 * 33], sp[3 * 33]); o.y = pk4_fp8(sp[4 * 33], sp[5 * 33], sp[6 * 33], sp[7 * 33]);
                o.z = pk4_fp8(sp[8 * 33], sp[9 * 33], sp[10 * 33], sp[11 * 33]); o.w = pk4_fp8(sp[12 * 33], sp[13 * 33], sp[14 * 33], sp[15 * 33]);
                const int nn = cn0 + n; const int dr = (cmap == 4) ? dest_row<4>(nn) : (cmap == 3 ? dest_row<3>(nn) : dest_row<2>(nn));
                *(GAS u32x4*)(cWT + (size_t)dr * cK + ck0 + 16 * c) = o; }
            LDS_WAIT(); asm volatile("" ::: "memory");
        }
    }
#undef CONV_DESC
}

__device__ __forceinline__ void moe_tables(Frame& F) {
    LAS int* tab = (LAS int*)(F.lds + TAB_OFF);
    __syncthreads();
    if (F.tid < 64) {
        const int c = (F.lane < 8) ? (int)__hip_atomic_load(F.ctl + CW_CNT + 64 * F.lane, RLX_AGENT) : 0, nt = (c + 255) >> 8;
        int tp = 0;
#pragma unroll
        for (int e = 0; e < 8; ++e) { const int v = __builtin_amdgcn_readlane(nt, e); tp += (F.lane > e) ? v : 0; }
        if (F.lane < 8) { tab[F.lane] = c; tab[8 + F.lane] = tp; }
        if (F.lane == 8) tab[16] = tp < MAXTILES ? tp : MAXTILES;
    }
    __syncthreads();
    for (int t = F.tid; t < tab[16]; t += NWAVES * 64) {
        int e = 0;
#pragma unroll
        for (int k = 1; k < 8; ++k) e = (t >= tab[8 + k]) ? k : e;
        tab[32 + t] = e; tab[32 + MAXTILES + t] = tab[8 + e];
    }
    __syncthreads();
}
struct MoeSched1 {
    static constexpr bool VAR_NT = false;
    pg8::StaticOrder so; int g0; const LAS int* tab; const char* X; const char* W; const int* list;
    __device__ __forceinline__ bool next(int i, pg8::Unit& u) const { return so.next(i, u); }
    __device__ __forceinline__ const char* a_base(const pg8::Unit&) const { return X; }
    __device__ __forceinline__ const char* b_base(const pg8::Unit& u) const { const int e = tab[32 + g0 + u.pm]; return W + (size_t)e * (2 * DFFE * D) + (size_t)u.pn * (256 * D); }
    __device__ __forceinline__ const int* tok_addr(const pg8::Unit& u, int row) const {
        const int G = g0 + u.pm, e = tab[32 + G], rt = G - tab[32 + MAXTILES + G], cnt = tab[e], slot = rt * 256 + row;
        return list + (size_t)e * T + (slot < cnt ? slot : 0);
    }
    __device__ __forceinline__ void a_rows_load(const pg8::Unit& u, const int (&R)[2], int (&tok)[2][2]) const {
        const int G = g0 + u.pm, e = tab[32 + G], rt = G - tab[32 + MAXTILES + G], cnt = tab[e];
#pragma unroll
        for (int h = 0; h < 2; ++h)
#pragma unroll
            for (int i = 0; i < 2; ++i) { const int slot = rt * 256 + 128 * h + R[i]; tok[h][i] = list[(size_t)e * T + (slot < cnt ? slot : 0)]; }
    }
    __device__ __forceinline__ void a_rows_off(const int (&tok)[2][2], int K, const int (&C)[2], unsigned (&off)[2][2]) const {
#pragma unroll
        for (int h = 0; h < 2; ++h)
#pragma unroll
            for (int i = 0; i < 2; ++i) off[h][i] = (unsigned)(tok[h][i] * K + C[i]) * 2u;
    }
    __device__ __forceinline__ void a_rows(const pg8::Unit& u, int K, const int (&R)[2], const int (&C)[2], unsigned (&off)[2][2]) const { int tok[2][2]; a_rows_load(u, R, tok); a_rows_off(tok, K, C, off); }
};
struct MoeSched2 {
    static constexpr bool VAR_NT = true;
    pg8::StaticOrder so; int ntail; const LAS int* tab; const char* H; const char* W;
    __device__ __forceinline__ static void decode(const pg8::Unit& u, int ntail, int& tile, int& kq) { if (u.pm >= Y2_TILE0) { kq = 1 + (u.pm - Y2_TILE0) / 8; tile = (u.pm - Y2_TILE0) % 8; } else { kq = 0; tile = u.pm; } (void)ntail; }
    __device__ __forceinline__ bool next(int i, pg8::Unit& u) const {
        if (so.next(i, u)) { u.pm = ntail + so.nM - 1 - u.pm; return true; }
        if (ntail == 0) return false;
        const int c = (i - 4) * so.G + so.c;
        if (i < 4 || c >= 16 * ntail) return false;
        const int tile = c >> 4, kq = c & 3; u.pn = (c >> 2) & 3; u.pm = kq ? Y2_TILE0 + 8 * (kq - 1) + tile : tile; return true;
    }
    __device__ __forceinline__ int ktiles(const pg8::Unit& u) const { if (u.pm >= ntail && u.pm < Y2_TILE0) return DFFE / 128; int tile, kq; decode(u, ntail, tile, kq); return kq < 2 ? 8 : 6; }
    __device__ __forceinline__ int koff(const pg8::Unit& u) const { if (u.pm >= ntail && u.pm < Y2_TILE0) return 0; int tile, kq; decode(u, ntail, tile, kq); return (kq == 0 ? 0 : kq == 1 ? 8 : kq == 2 ? 16 : 22) * 128; }
    __device__ __forceinline__ int tile_of(const pg8::Unit& u) const { int tile, kq; decode(u, ntail, tile, kq); return tile; }
    __device__ __forceinline__ const char* a_base(const pg8::Unit& u) const { return H + (size_t)tile_of(u) * (256 * DFFE) + koff(u); }
    __device__ __forceinline__ const char* b_base(const pg8::Unit& u) const { const int e = tab[32 + tile_of(u)]; return W + (size_t)e * (D * DFFE) + (size_t)u.pn * (256 * DFFE) + koff(u); }
    __device__ __forceinline__ void a_rows(const pg8::Unit&, int, const int (&)[2], const int (&)[2], unsigned (&)[2][2]) const {}
};

__device__ __forceinline__ void final_phase(Frame& F) {
    const int gw = F.vcu * NWAVES + F.wave, NGW = F.G * NWAVES, lane = F.lane;
    const LAS int* tab = (const LAS int*)(F.lds + TAB_OFF);
    const int* tinfo = (const int*)(F.ws + WS_TOKINFO); const unsigned char* yb = F.ws + WS_Y; const bf16* xb = (const bf16*)(F.ws + WS_XB);
    f32x4 lw[4], lb[4], lw2[4], lb2[4];
#pragma unroll
    for (int j = 0; j < 4; ++j) { lw[j] = ((const GAS f32x4*)(F.ln_w + 3 * D))[lane + 64 * j]; lb[j] = ((const GAS f32x4*)(F.ln_b + 3 * D))[lane + 64 * j];
        lw2[j] = ((const GAS f32x4*)(F.ln_w + 2 * D))[lane + 64 * j] * ALPHA; lb2[j] = ((const GAS f32x4*)(F.ln_b + 2 * D))[lane + 64 * j] * ALPHA; }
    const int lrows = (F.G == 256 && tab[16] > 256 && tab[16] <= 264) ? (tab[16] - 256) * 256 : 0;
    const unsigned char* y2 = F.ws + WS_Y2;
    struct Rows { u32x2 x[4]; unsigned a[4], c[4]; float g0, g1; int l0, l1; };
    Rows RA, RB; u32x4 iv4 = {0u, 0u, 0u, 0u}; u32x2 iv2 = {0u, 0u};
#define FIN_LOAD_INFO(mm) do { if ((mm) < T) { const int* ti_ = tinfo + (size_t)(mm) * 6; iv4 = *(const GAS u32x4*)ti_; iv2 = *(const GAS u32x2*)(ti_ + 4); } } while (0)
#define FIN_LOAD_ROWS(R, mm) do { if ((mm) < T) { const int t0_ = __builtin_amdgcn_readfirstlane((int)iv4.x), t1_ = __builtin_amdgcn_readfirstlane((int)iv4.y), t2_ = __builtin_amdgcn_readfirstlane((int)iv4.z), \
            t3_ = __builtin_amdgcn_readfirstlane((int)iv4.w), t4_ = __builtin_amdgcn_readfirstlane((int)iv2.x), t5_ = __builtin_amdgcn_readfirstlane((int)iv2.y); \
        const int r0_ = tab[8 + t0_] * 256 + t1_, r1_ = tab[8 + t3_] * 256 + t4_; R.g0 = __int_as_float(t2_) * (1.0f / Y_SCALE); R.g1 = __int_as_float(t5_) * (1.0f / Y_SCALE); \
        R.l0 = __builtin_amdgcn_readfirstlane(r0_) < lrows ? __builtin_amdgcn_readfirstlane(r0_) : -1; R.l1 = __builtin_amdgcn_readfirstlane(r1_) < lrows ? __builtin_amdgcn_readfirstlane(r1_) : -1; \
        FIN_LOAD_INFO((mm) + NGW); \
        _Pragma("unroll") for (int j_ = 0; j_ < 4; ++j_) { R.x[j_] = __builtin_nontemporal_load((const GAS u32x2*)(xb + (size_t)(mm) * D) + lane + 64 * j_); R.a[j_] = __builtin_nontemporal_load((const GAS unsigned*)(yb + (size_t)r0_ * D) + lane + 64 * j_); \
            R.c[j_] = __builtin_nontemporal_load((const GAS unsigned*)(yb + (size_t)r1_ * D) + lane + 64 * j_); } } } while (0)
#define FIN_ROW(R, m) do { f32x4 v[4]; float s = 0.f; const float g0 = R.g0, g1 = R.g1; const int l0 = R.l0, l1 = R.l1; unsigned ya[4], yc[4]; \
        _Pragma("unroll") for (int j = 0; j < 4; ++j) { v[j] = bf_lo4(R.x[j]); ya[j] = R.a[j]; yc[j] = R.c[j]; s += (v[j].x + v[j].y) + (v[j].z + v[j].w); } \
        FIN_LOAD_ROWS(R, (m) + 2 * NGW); \
        const float mean3 = wave_sum(s) * (1.f / D); float q3 = 0.f; s = 0.f; \
        _Pragma("unroll") for (int j = 0; j < 4; ++j) { v[j] = v[j] - mean3; q3 += (v[j].x * v[j].x + v[j].y * v[j].y) + (v[j].z * v[j].z + v[j].w * v[j].w); } \
        const float rstd3 = 1.f / sqrtf(wave_sum(q3) * (1.f / D) + LN_EPS); \
        _Pragma("unroll") for (int j = 0; j < 4; ++j) v[j] = (v[j] * rstd3 * lw2[j] + lb2[j]) + (fp8x4(ya[j]) * g0 + fp8x4(yc[j]) * g1); \
        if (l0 >= 0) { _Pragma("unroll") for (int pl = 0; pl < 3; ++pl) _Pragma("unroll") for (int j = 0; j < 4; ++j) v[j] = v[j] + fp8x4(*((const GAS unsigned*)(y2 + ((size_t)pl * 2048 + l0) * D) + lane + 64 * j)) * g0; } \
        if (l1 >= 0) { _Pragma("unroll") for (int pl = 0; pl < 3; ++pl) _Pragma("unroll") for (int j = 0; j < 4; ++j) v[j] = v[j] + fp8x4(*((const GAS unsigned*)(y2 + ((size_t)pl * 2048 + l1) * D) + lane + 64 * j)) * g1; } \
        _Pragma("unroll") for (int j = 0; j < 4; ++j) s += (v[j].x + v[j].y) + (v[j].z + v[j].w); \
        const float mean = wave_sum(s) * (1.f / D); float s2 = 0.f; \
        _Pragma("unroll") for (int j = 0; j < 4; ++j) { v[j] = v[j] - mean; s2 += (v[j].x * v[j].x + v[j].y * v[j].y) + (v[j].z * v[j].z + v[j].w * v[j].w); } \
        const float rstd = 1.f / sqrtf(wave_sum(s2) * (1.f / D) + LN_EPS); \
        GAS f32x4* xr = (GAS f32x4*)(F.res + (size_t)(m) * D) + lane; \
        _Pragma("unroll") for (int j = 0; j < 4; ++j) __builtin_nontemporal_store(v[j] * rstd * lw[j] + lb[j], xr + 64 * j); } while (0)
    FIN_LOAD_INFO(gw); FIN_LOAD_ROWS(RA, gw); FIN_LOAD_ROWS(RB, gw + NGW);
    for (int m = gw; m < T; m += 2 * NGW) {
        FIN_ROW(RA, m);
        if (m + NGW < T) FIN_ROW(RB, m + NGW);
    }
#undef FIN_ROW
#undef FIN_LOAD_INFO
#undef FIN_LOAD_ROWS
}

constexpr int N_PHASES = 16;
struct Args { const void* in[19]; float* out; unsigned char* ws; int ph_lo, ph_hi; };
__global__ void __launch_bounds__(NWAVES * 64, 2) skel_fwd(Args args) {
    extern __shared__ __attribute__((aligned(16))) unsigned char lds[];
    Frame F;
    F.lds = (LAS unsigned char*)lds;
    F.MISC = (volatile LAS unsigned*)(F.lds + MISC_OFF);
    F.tid = threadIdx.x; F.lane = F.tid & 63; F.wave = __builtin_amdgcn_readfirstlane(F.tid >> 6);
    F.G = gridDim.x; { const int bx = blockIdx.x; F.vcu = (F.G % 8 == 0) ? (bx % 8) * (F.G / 8) + bx / 8 : bx; }
    F.ws = args.ws; F.ctl = (gu32*)(args.ws + WS_CTL); F.res = args.out;
    F.x = (const float*)args.in[0]; F.pos = (const int*)args.in[1]; F.ln_w = (const float*)args.in[2]; F.ln_b = (const float*)args.in[3];
    F.even_w_in = (const float*)args.in[4]; F.pool_w = (const float*)args.in[5]; F.pool_scale = (const float*)args.in[6]; F.sinks = (const float*)args.in[7];
    F.even_w_out = (const float*)args.in[8]; F.ffn_wg = (const float*)args.in[9]; F.ffn_wu = (const float*)args.in[10]; F.ffn_wd = (const float*)args.in[11];
    F.odd_w_in = (const float*)args.in[12]; F.conv_w = (const float*)args.in[13]; F.odd_w_out = (const float*)args.in[14]; F.router_w = (const float*)args.in[15];
    F.moe_wg = (const float*)args.in[16]; F.moe_wu = (const float*)args.in[17]; F.moe_wd = (const float*)args.in[18];
    for (int u = F.tid; u < (LDS_BYTES - LDSCTL_OFF) / 4; u += NWAVES * 64) ((LAS unsigned*)(F.lds + LDSCTL_OFF))[u] = 0u;
    __syncthreads();
    if (F.tid < 32) {
        const double c = ROPE_INV_FREQ[F.tid] * 0.15915494309189533577;
        const float chi = __uint_as_float(__float_as_uint((float)c) & 0xffffe000u), clo = (float)(c - (double)chi);
        ((LAS float*)(F.lds + ROPEC_OFF))[F.tid] = chi; ((LAS float*)(F.lds + ROPEC_OFF))[32 + F.tid] = clo;
    }
    __syncthreads();
    XcdBarrier bar; bar.bar = (unsigned*)(F.ctl + CW_BAR); bar.x = 0; bar.st = nullptr;
    if (!MK_PER_PHASE) bar = xcd_barrier_post((unsigned*)(F.ctl + CW_BAR), F.MISC + 8);
    const int lo = args.ph_lo, hi = args.ph_hi;
#define IN(k) (lo <= (k) && (k) < hi)
#define SEAM(k) do { if (IN(k) && IN((k) + 1)) xcd_barrier(bar); } while (0)
    const int bid = (int)blockIdx.x;
    bf16* XB = (bf16*)(F.ws + WS_XB);

    if (IN(0)) { p0_prologue(F); SEAM(0); }
    if (IN(1)) {
        pg8::PlainSched S; S.so.init(T / 256, EVEN_IN / 256, F.G, bid); S.A = (const char*)XB; S.B = (const char*)(F.ws + WS_WEIN); S.tstep = (size_t)256 * D * 2;
        EpiY E{(bf16*)(F.ws + WS_H0), 0, 1.0f, EVEN_IN};
        pg8::gemm_phase<false, false>(F.lds, D, S, E); SEAM(1);
    }
    if (IN(2)) {
        {
        for (int u = F.vcu; u < 512; u += F.G) {
            const int b = u >> 6, kvh = (u >> 4) & 3, blk = u & 15;
            AttnUnit U; U.src = (const bf16*)(F.ws + WS_H0); U.ld = EVEN_IN; U.rowbase = b * SEQ; U.rstride = 1; U.i0 = 256 * blk;
            U.qcol0 = 256 + 64 * 3 * kvh; U.nh = 3; U.kcol = 1024 + 64 * kvh; U.vcol = 1280 + 64 * kvh;
            U.O = (bf16*)(F.ws + WS_M0); U.ldo = D; U.ocol0 = 256 + 64 * 3 * kvh; U.lse = nullptr; U.lse_h0 = 0; U.sinks = F.sinks; U.sink_h0 = 3 * kvh; U.maxdist = 127; U.pos = F.pos;
            attn_unit<3>(F, U);
        }
        for (int u = F.vcu; u < 256; u += F.G) pool_unit(F, u);
        }
        SEAM(2);
    }
    if (IN(3)) {
        pg8::PlainSched S; S.so.init(T / 256, D / 256, F.G, bid); S.A = (const char*)(F.ws + WS_M0); S.B = (const char*)(F.ws + WS_WEOUT); S.tstep = (size_t)256 * D * 2;
        EpiResid E{XB, 1.0f};
        pg8::gemm_phase<false, false>(F.lds, D, S, E); SEAM(3);
    }
    if (IN(4)) { ln_phase(F, 0); SEAM(4); }
    if (IN(5)) {
        pg8::PlainSched S; S.so.init(T / 256, 2 * DFF / 256, F.G, bid); S.A = (const char*)XB; S.B = (const char*)(F.ws + WS_WGU); S.tstep = (size_t)256 * D * 2;
        EpiSwiglu8<false> E{F.ws + WS_HF, DFF};
        pg8::gemm_phase<false, false>(F.lds, D, S, E);
        SEAM(5);
    }
    if (IN(6)) {
        pg8::PlainSched S; S.so.init(T / 256, D / 256, F.G, bid); S.A = (const char*)(F.ws + WS_HF); S.B = (const char*)(F.ws + WS_WDN); S.tstep = (size_t)256 * DFF; S.rev = 1;
        EpiResidT<true> E{XB, 1.0f / (H_SCALE * W2_SCALE)};
        pg8::gemm_phase<false, true>(F.lds, DFF / 2, S, E); SEAM(6);
    }
    if (IN(7)) { ln_phase(F, 1); SEAM(7); }
    if (IN(8)) {
        pg8::PlainSched S; S.so.init(T / 256, ODD_IN / 256, F.G, bid); S.A = (const char*)XB; S.B = (const char*)(F.ws + WS_WOIN); S.tstep = (size_t)256 * D * 2;
        EpiYConv E{(bf16*)(F.ws + WS_H1)};
        pg8::gemm_phase<false, false>(F.lds, D, S, E); SEAM(8);
    }
    if (IN(9)) {
        if (bid & 1) for (int c = F.vcu; c < T / 128; c += F.G) conv_chunk(F, c);
        for (int u = F.vcu; u < 768; u += F.G) {
            const int g = u >> 8, v = u & 255, b = v >> 5, w = v & 31, kvh = w >> 4, xx = w & 15;
            const int dil = (g == 0) ? 1 : (g == 1) ? 4 : 16; const int r = xx % dil, blk = xx / dil;
            AttnUnit U; U.src = (const bf16*)(F.ws + WS_H1); U.ld = ODD_IN; U.rowbase = b * SEQ + r; U.rstride = dil; U.i0 = 256 * blk;
            U.qcol0 = 768 * g + 64 * 4 * kvh; U.nh = 4; U.kcol = 768 * g + 512 + 64 * kvh; U.vcol = 768 * g + 640 + 64 * kvh;
            U.O = (bf16*)(F.ws + WS_OG + (size_t)g * T * 512); U.ldo = 512; U.ocol0 = 64 * 4 * kvh; U.o8 = 1;
            U.lse = (float*)(F.ws + WS_LSE) + (size_t)g * T * 8; U.lse_h0 = 4 * kvh; U.sinks = nullptr; U.sink_h0 = 0; U.maxdist = 128; U.pos = F.pos;
            attn_unit<4>(F, U);
        }
        if (!(bid & 1)) for (int c = F.vcu; c < T / 128; c += F.G) conv_chunk(F, c);
        SEAM(9);
    }
    if (IN(10)) { merge_phase(F); SEAM(10); }
    if (IN(11)) {
        pg8::PlainSched S; S.so.init(T / 256, D / 256, F.G, bid); S.A = (const char*)(F.ws + WS_M1); S.B = (const char*)(F.ws + WS_WOOUT); S.tstep = (size_t)256 * D * 2;
        EpiResid E{XB, 1.0f};
        pg8::gemm_phase<false, false>(F.lds, D, S, E); SEAM(11);
    }
    if (IN(12)) { router_phase(F); SEAM(12); }
    if (IN(13)) {
        moe_tables(F);
        const LAS int* tab = (const LAS int*)(F.lds + TAB_OFF);
        MoeSched1 S; S.so.init(tab[16], 2 * DFFE / 256, F.G, bid); S.g0 = 0; S.tab = tab; S.X = (const char*)F.res + DO_X8; S.W = (const char*)F.res + DO_WM8; S.list = (const int*)(F.ws + WS_LIST);
        EpiSwiglu8<true> E{F.ws + WS_HC8, DFFE};
        pg8::gemm_phase<true, true>(F.lds, D / 2, S, E); SEAM(13);
    }
    if (IN(14)) {
        if (!IN(13)) moe_tables(F);
        const LAS int* tab = (const LAS int*)(F.lds + TAB_OFF);
        const int ntail = (F.G == 256 && tab[16] > 256 && tab[16] <= 264) ? tab[16] - 256 : 0;
        MoeSched2 S; S.so.init(tab[16] - ntail, D / 256, F.G, bid); S.ntail = ntail; S.tab = tab; S.H = (const char*)(F.ws + WS_HC8); S.W = (const char*)F.res + DO_WMD8;
        EpiY8 E{F.ws + WS_Y, Y_SCALE / (H_SCALE * W2_SCALE)};
        pg8::gemm_phase<false, true>(F.lds, DFFE / 2, S, E);
        SEAM(14);
    }
    if (IN(N_PHASES - 1)) { if (!IN(13)) moe_tables(F); final_phase(F); }
#undef IN
#undef SEAM
}

extern "C" void kernel_launch(void* const* d_in, const int* in_sizes, int n_in, void* d_out, int out_size, void* d_ws, size_t ws_size, hipStream_t stream) {
    static int grid = 0;
    if (grid == 0) {
        if (n_in != 19 || out_size != T * D || ws_size < WS_END) { fprintf(stderr, "kernel_launch: unexpected sizes (n_in %d out %d ws %zu, need %zu)\n", n_in, out_size, ws_size, (size_t)WS_END); grid = -1; return; }
        int dev = 0, cus = 0, per_cu = 0;
        if (hipGetDevice(&dev) != hipSuccess || hipDeviceGetAttribute(&cus, hipDeviceAttributeMultiprocessorCount, dev) != hipSuccess) { grid = -1; return; }
        if (hipFuncSetAttribute((const void*)skel_fwd, hipFuncAttributeMaxDynamicSharedMemorySize, LDS_BYTES) != hipSuccess) { fprintf(stderr, "kernel_launch: hipFuncSetAttribute failed\n"); grid = -1; return; }
        if (hipOccupancyMaxActiveBlocksPerMultiprocessor(&per_cu, (const void*)skel_fwd, NWAVES * 64, LDS_BYTES) != hipSuccess || per_cu < 1) fprintf(stderr, "kernel_launch: occupancy query reports %d\n", per_cu);
        (void)hipGetLastError();
        grid = cus;
    }
    if (grid < 0) return;
    (void)in_sizes;
    if (hipMemsetAsync((char*)d_ws + WS_CTL, 0, CTL_ZERO_BYTES, stream) != hipSuccess) return;
    Args a{};
    for (int i = 0; i < 19; ++i) a.in[i] = d_in[i];
    a.out = (float*)d_out; a.ws = (unsigned char*)d_ws;
#if MK_PER_PHASE
    for (int p = 0; p < N_PHASES; ++p) { a.ph_lo = p; a.ph_hi = p + 1; hipLaunchKernelGGL(skel_fwd, dim3(grid), dim3(NWAVES * 64), LDS_BYTES, stream, a); }
#else
    a.ph_lo = 0; a.ph_hi = N_PHASES;
    hipLaunchKernelGGL(skel_fwd, dim3(grid), dim3(NWAVES * 64), LDS_BYTES, stream, a);
#endif
}
```

```cpp
#include <hip/hip_runtime.h>
#include <cstdio>
#include <cstdint>
#include <type_traits>

#define GAS __attribute__((address_space(1)))
#define LAS __attribute__((address_space(3)))
typedef unsigned short bf16;
typedef short bf16x8 __attribute__((ext_vector_type(8)));
typedef short s16x4 __attribute__((ext_vector_type(4)));
typedef float f32x4 __attribute__((ext_vector_type(4)));
typedef float f32x16 __attribute__((ext_vector_type(16)));
typedef float f32x2 __attribute__((ext_vector_type(2)));
typedef unsigned u32x4 __attribute__((ext_vector_type(4)));
typedef unsigned u32x2 __attribute__((ext_vector_type(2)));
typedef GAS unsigned gu32;
typedef int v4i_t __attribute__((ext_vector_type(4)));
typedef int v8i_t __attribute__((ext_vector_type(8)));

#ifndef MK_PER_PHASE
#define MK_PER_PHASE 0
#endif

constexpr int NB = 8, SEQ = 4096, T = NB * SEQ, D = 1024;
constexpr int EVEN_IN = 1536, ODD_IN = 3840, DFF = 2816, DFFE = 3584, NE = 8;
constexpr float ALPHA = 1.41421356237309515f;
constexpr float LN_EPS = 1e-5f;
constexpr float C2 = 0.125f * 1.4426950408889634f;
constexpr float LOG2E = 1.4426950408889634f;
constexpr int NWAVES = 8;
constexpr int MAXTILES = 264;
constexpr float W1_SCALE = 32.f, W2_SCALE = 128.f, H_SCALE = 4.f, M_SCALE = 2.f, OG_SCALE = 8.f, Y_SCALE = 16.f, QKV_SCALE = 4.f;

constexpr size_t MiB = 1u << 20;
constexpr size_t WS_CTL = 0, CTL_ZERO_BYTES = 32 * 1024;
constexpr size_t WS_POOLWT = 1 * MiB;
constexpr size_t WS_LIST = 2 * MiB;
constexpr size_t WS_TOKINFO = 3 * MiB;
constexpr size_t WS_LSE = 4 * MiB;
constexpr size_t WS_WOOUT = 8 * MiB;
constexpr size_t WS_XB = 10 * MiB;
constexpr size_t WS_ROPE = 74 * MiB;
constexpr size_t WS_WEIN = 82 * MiB;
constexpr size_t WS_WEOUT = 85 * MiB;
constexpr size_t WS_WGU = 87 * MiB;
constexpr size_t WS_WDN = 98 * MiB;
constexpr size_t WS_WOIN = 104 * MiB;
constexpr size_t WS_BIG = 112 * MiB;
constexpr size_t WS_H0 = WS_BIG;
constexpr size_t WS_M0 = WS_BIG + 96 * MiB;
constexpr size_t WS_HF = WS_BIG;
constexpr size_t WS_H1 = WS_BIG;
constexpr size_t WS_M1 = WS_BIG + 240 * MiB;
constexpr size_t WS_OG = WS_BIG + 304 * MiB;
constexpr size_t DO_X8 = 0;
constexpr size_t DO_H1A8 = 0;
constexpr size_t DO_X2_8 = 80 * MiB;
constexpr size_t DO_WM8 = 32 * MiB;
constexpr size_t DO_WMD8 = DO_WM8 + 56 * MiB;
constexpr size_t WS_Y = 112 * MiB;
constexpr size_t WS_HC8 = 244 * MiB;
constexpr size_t WS_Y2 = 476 * MiB;
constexpr int Y2_TILE0 = (int)((WS_Y2 - WS_Y) / ((size_t)256 * D));
constexpr size_t WS_WGU8 = 101 * MiB;
constexpr int NF8 = 12;
constexpr size_t WS_END = 512 * MiB;
constexpr int CW_TMO = 0, CW_CODE = 1;
constexpr int CW_CNT = 1024;
constexpr int CW_BAR = 4096;
constexpr int CW_DCV = 2048;

constexpr int RING_BYTES = 131072;
constexpr int LDSCTL_OFF = RING_BYTES, MISC_OFF = LDSCTL_OFF + 320;
constexpr int TAB_OFF = MISC_OFF + 128 + 64;
constexpr int ROPEC_OFF = 135168;
constexpr int TOK_OFF = ROPEC_OFF + 256;
constexpr int LDS_BYTES = 147456;

#define RLX_AGENT __ATOMIC_RELAXED, __HIP_MEMORY_SCOPE_AGENT
#define LDS_WAIT() asm volatile("s_waitcnt lgkmcnt(0)" ::: "memory")
#define VM_WAIT() asm volatile("s_waitcnt vmcnt(0)" ::: "memory")

__device__ __forceinline__ float bf2f(unsigned short b) { return __uint_as_float((unsigned)b << 16); }
__device__ __forceinline__ unsigned f2bf(float f) { unsigned u = __float_as_uint(f); return (u + 0x7fffu + ((u >> 16) & 1u)) >> 16; }
__device__ __forceinline__ unsigned pk2(float lo, float hi) { return f2bf(lo) | (f2bf(hi) << 16); }
typedef __bf16 bf16x2_t __attribute__((ext_vector_type(2)));
__device__ __forceinline__ unsigned cvtpk(float lo, float hi) { f32x2 v = {lo, hi}; bf16x2_t b = __builtin_convertvector(v, bf16x2_t); return __builtin_bit_cast(unsigned, b); }
__device__ __forceinline__ float wave_sum(float v) {
#pragma unroll
    for (int o = 1; o < 64; o <<= 1) v += __shfl_xor(v, o);
    return v;
}

template <int MAP> __host__ __device__ __forceinline__ int dest_row(int n) {
    if (MAP == 0) return n;
    if (MAP == 4) { const int g = n & ~31, i = n & 31, fq = i >> 3, nn = (i >> 2) & 1, e = i & 3; return g + 16 * nn + 4 * fq + e; }
    if (MAP == 1) { const int tile = n >> 8, c = n & 255, hd = c >> 6, half = (c >> 5) & 1, i = c & 31;
        const int bj = hd >> 1, wc = 2 * (hd & 1) + (i >> 4), fq = (i >> 2) & 3, e = i & 3;
        return 256 * tile + 128 * bj + 32 * wc + 16 * half + 4 * fq + e; }
    const int which = MAP - 2, tile = n >> 7, jj = n & 127, wc = jj >> 5, fq = (jj >> 3) & 3, bj = (jj >> 2) & 1, e = jj & 3;
    return 256 * tile + 128 * bj + 32 * wc + 16 * which + 4 * fq + e;
}

namespace pg8 {
constexpr int BM = 256, BK = 64, HALF = 128, HTB = HALF * BK * 2, STAGE_BYTES = 8 * HTB, NXCD = 8, WGM = 8;
__host__ __device__ __forceinline__ int lds_byte(int r, int c) { const int st = (r >> 4) * 2 + (c >> 5), rr = r & 15, cc = c & 31, ob = rr * 64 + cc * 2; return st * 1024 + (ob ^ (((ob >> 9) & 1) << 5)); }
__host__ __device__ __forceinline__ void stage_rc(int b, int& R, int& C) { const int st = b / 1024, sb = b % 1024, swz = sb ^ (((sb >> 9) & 1) << 5); R = (st >> 1) * 16 + swz / 64; C = (st & 1) * 32 + (swz % 64) / 2; }
struct Unit { int pm, pn; };
struct StaticOrder {
    int nM, nN, nwg, G, c;
    __host__ __device__ void init(int nM_, int nN_, int G_, int c_) { nM = nM_; nN = nN_; nwg = nM * nN; G = G_; c = c_; }
    __host__ __device__ bool next(int i, Unit& u) const {
        const long L = (long)i * G + c; if (L >= nwg) return false;
        int wgid = (int)L; { const int q = nwg / NXCD, r = nwg % NXCD, xcd = wgid % NXCD, off = wgid / NXCD; wgid = (xcd < r ? xcd * (q + 1) : r * (q + 1) + (xcd - r) * q) + off; }
        const int nig = WGM * nN, gid = wgid / nig, fm = gid * WGM, gsz = (nM - fm) < WGM ? (nM - fm) : WGM;
        u.pm = fm + ((wgid % nig) % gsz); u.pn = (wgid % nig) / gsz; return true;
    }
};
struct PlainSched {
    static constexpr bool VAR_NT = false, MIXED = false;
    StaticOrder so; const char* A; const char* B; size_t tstep; int rev = 0;
    __device__ __forceinline__ bool next(int i, Unit& u) const { const bool ok = so.next(i, u); if (rev) u.pm = so.nM - 1 - u.pm; return ok; }
    __device__ __forceinline__ const char* a_base(const Unit& u) const { return A + (size_t)u.pm * tstep; }
    __device__ __forceinline__ const char* b_base(const Unit& u) const { return B + (size_t)u.pn * tstep; }
    __device__ __forceinline__ void a_rows(const Unit&, int, const int (&)[2], const int (&)[2], unsigned (&)[2][2]) const {}
};

struct MixSched : PlainSched { static constexpr bool MIXED = true; int nt8; };

template <class Epi> struct gate_shift { static constexpr int value = 0; };
template <bool GATHER, bool FP8, class Epi, class Sched>
__device__ __forceinline__ void gemm_phase(LAS unsigned char* lds, const int K, const Sched& S, const Epi& E, const int nt_part = 0) {
    const int tid = threadIdx.x, wid = __builtin_amdgcn_readfirstlane(tid >> 6), lane = tid & 63, wr = wid >> 2, wc = wid & 3, fr = lane & 15, fq = lane >> 4;
    int nt = nt_part ? nt_part : K / BK;
    unsigned voffA[2], voffB[2]; int Rr[2], Cc[2];
#pragma unroll
    for (int i = 0; i < 2; ++i) { int R, C; stage_rc(tid * 16 + i * 8192, R, C); Rr[i] = R; Cc[i] = C; voffA[i] = (unsigned)(R * K + C) * 2u; voffB[i] = voffA[i]; }
    const size_t kstep = (size_t)(BK * 2);
    const size_t hstep = (size_t)HALF * K * 2;
    const unsigned ldsw = (unsigned)wid * 1024u;
    const int aoff = lds_byte(wr * 64 + fr, fq * 8), boff = lds_byte(wc * 32 + fr, fq * 8);
    unsigned vA[2][2], vAn[2][2];
#define PG8_SA(b, h) (((b) * 2 + (h)) * HTB)
#define PG8_SB(b, h) ((4 + (b) * 2 + (h)) * HTB)
#define PG8_STAGE(bufoff, gbase, voff) do { _Pragma("unroll") for (int _i = 0; _i < 2; ++_i) \
        __builtin_amdgcn_global_load_lds((const unsigned*)((const char*)(gbase) + (voff)[_i]), (LAS unsigned*)(lds + (bufoff) + ldsw + _i * 8192), 16, 0, 0); } while (0)
#define PG8_STA(bufoff, kptr, h, useN) do { if constexpr (GATHER) { _Pragma("unroll") for (int _i = 0; _i < 2; ++_i) { const unsigned _o = (useN) ? vAn[h][_i] : vA[h][_i]; \
        __builtin_amdgcn_global_load_lds((const unsigned*)((const char*)(kptr) + _o), (LAS unsigned*)(lds + (bufoff) + ldsw + _i * 8192), 16, 0, 0); } } \
        else { PG8_STAGE(bufoff, (kptr) + (h) * hstep, voffA); } } while (0)
#define PG8_LDA(dst, b, h) do { _Pragma("unroll") for (int m = 0; m < 4; ++m) _Pragma("unroll") for (int k = 0; k < 2; ++k) dst[m][k] = *(const LAS bf16x8*)(lds + PG8_SA(b, h) + aoff + m * 2048 + k * 1024); } while (0)
#define PG8_LDB(dst, b, h) do { _Pragma("unroll") for (int n = 0; n < 2; ++n) _Pragma("unroll") for (int k = 0; k < 2; ++k) dst[n][k] = *(const LAS bf16x8*)(lds + PG8_SB(b, h) + boff + n * 2048 + k * 1024); } while (0)
#define PG8_MMA(ai, bj, At, Bt) do { __builtin_amdgcn_s_setprio(1); _Pragma("unroll") for (int m = 0; m < 4; ++m) _Pragma("unroll") for (int n = 0; n < 2; ++n) _Pragma("unroll") for (int k = 0; k < 2; ++k) \
        asm volatile("v_mfma_f32_16x16x32_bf16 %0, %1, %2, %0" : "+v"(acc[ai][bj][m][n]) : "v"(Bt[n][k]), "v"(At[m][k])); __builtin_amdgcn_s_setprio(0); } while (0)
#define PG8_LD8(p) __builtin_shufflevector(*(const LAS v4i_t*)(p), *(const LAS v4i_t*)((p) + 1024), 0, 1, 2, 3, 4, 5, 6, 7)
#define PG8_LDA8(dst, b, h) do { _Pragma("unroll") for (int m = 0; m < 4; ++m) dst[m] = PG8_LD8(lds + PG8_SA(b, h) + aoff + m * 2048); } while (0)
#define PG8_LDB8(dst, b, h) do { _Pragma("unroll") for (int n = 0; n < 2; ++n) dst[n] = PG8_LD8(lds + PG8_SB(b, h) + boff + n * 2048); } while (0)
#define PG8_MMA8(ai, bj, At, Bt) do { __builtin_amdgcn_s_setprio(1); _Pragma("unroll") for (int m = 0; m < 4; ++m) _Pragma("unroll") for (int n = 0; n < 2; ++n) \
        asm volatile("v_mfma_scale_f32_16x16x128_f8f6f4 %0, %1, %2, %0, %3, %4 op_sel_hi:[0,0,0]" : "+v"(acc[ai][bj][m][n]) : "v"(Bt[n]), "v"(At[m]), "v"(n == 0 ? gsc8 : one8), "v"(one8)); __builtin_amdgcn_s_setprio(0); } while (0)
#define PG8_MMA8F(ai, bj, At, Bt) do { __builtin_amdgcn_s_setprio(1); _Pragma("unroll") for (int m = 0; m < 4; ++m) _Pragma("unroll") for (int n = 0; n < 2; ++n) \
        asm volatile("v_mfma_scale_f32_16x16x128_f8f6f4 %0, %1, %2, 0, %3, %4 op_sel_hi:[0,0,0]" : "+v"(acc[ai][bj][m][n]) : "v"(Bt[n]), "v"(At[m]), "v"(n == 0 ? gsc8 : one8), "v"(one8)); __builtin_amdgcn_s_setprio(0); } while (0)
#define PG8_MM(ai, bj, At_, B_) do { if constexpr (FP8) { if constexpr (Sched::MIXED) { if (seg16) PG8_MMA(ai, bj, At_, B_); else PG8_MMA8(ai, bj, At8, B_##8); } else PG8_MMA8(ai, bj, At8, B_##8); } else PG8_MMA(ai, bj, At_, B_); } while (0)
#define PG8_MMAF(ai, bj, At, Bt) do { __builtin_amdgcn_s_setprio(1); _Pragma("unroll") for (int m = 0; m < 4; ++m) _Pragma("unroll") for (int n = 0; n < 2; ++n) { \
        asm volatile("v_mfma_f32_16x16x32_bf16 %0, %1, %2, 0" : "+v"(acc[ai][bj][m][n]) : "v"(Bt[n][0]), "v"(At[m][0])); asm volatile("v_mfma_f32_16x16x32_bf16 %0, %1, %2, %0" : "+v"(acc[ai][bj][m][n]) : "v"(Bt[n][1]), "v"(At[m][1])); } \
        __builtin_amdgcn_s_setprio(0); } while (0)
#define PG8_MM0(ai, bj, At_, B_) do { if constexpr (FP8) PG8_MMA8F(ai, bj, At8, B_##8); else PG8_MMAF(ai, bj, At_, B_); } while (0)
#define PG8_LA(At_, b, h) do { if constexpr (FP8) { if constexpr (Sched::MIXED) { if (seg16) PG8_LDA(At_, b, h); else PG8_LDA8(At8, b, h); } else PG8_LDA8(At8, b, h); } else PG8_LDA(At_, b, h); } while (0)
#define PG8_LB(B_, b, h) do { if constexpr (FP8) { if constexpr (Sched::MIXED) { if (seg16) PG8_LDB(B_, b, h); else PG8_LDB8(B_##8, b, h); } else PG8_LDB8(B_##8, b, h); } else PG8_LDB(B_, b, h); } while (0)
#define PG8_WAIT_V(n) asm volatile("s_waitcnt vmcnt(" #n ")" ::: "memory")
#define PG8_WAIT_L(n) asm volatile("s_waitcnt lgkmcnt(" #n ")" ::: "memory")
#define PG8_BAR __builtin_amdgcn_s_barrier()
#define PG8_SCHED __builtin_amdgcn_sched_barrier(0)
    Unit cur, nxt; int ui = 0;
    if (!S.next(0, cur)) return;
    f32x4 acc[2][2][4][2];
#pragma unroll
    for (int a = 0; a < 2; ++a)
#pragma unroll
        for (int b = 0; b < 2; ++b)
#pragma unroll
            for (int m = 0; m < 4; ++m)
#pragma unroll
                for (int n = 0; n < 2; ++n) { asm volatile("" : "=v"(acc[a][b][m][n])); }
    bf16x8 At[4][2], B0[2][2], B1[2][2]; v8i_t At8[4], B08[2], B18[2]; int one8 = 0x7f7f7f7f; asm volatile("" : "+v"(one8));
    int gsc8 = 0x7f7f7f7f - 0x01010101 * gate_shift<Epi>::value; asm volatile("" : "+v"(gsc8));
    const char* cA = S.a_base(cur); const char* cB = S.b_base(cur);
    if constexpr (GATHER) { S.a_rows(cur, K, Rr, Cc, vA); }
    PG8_STAGE(PG8_SB(0, 0), cB, voffB); PG8_STAGE(PG8_SB(0, 1), cB + hstep, voffB); PG8_STA(PG8_SA(0, 0), cA, 0, false); PG8_STA(PG8_SA(0, 1), cA, 1, false);
    if (wr == 1) PG8_BAR;
    PG8_WAIT_V(2); PG8_BAR;
    PG8_STAGE(PG8_SB(1, 0), cB + kstep, voffB); PG8_STA(PG8_SA(1, 0), cA + kstep, 0, false); PG8_STAGE(PG8_SB(1, 1), cB + hstep + kstep, voffB);
    PG8_WAIT_V(6); PG8_BAR;
    for (;;) {
        if constexpr (Sched::VAR_NT) nt = S.ktiles(cur);
        bool has_next = false; const char* nA = cA; const char* nB = cB;
#define PG8_NEXT_UNIT() do { has_next = S.next(ui + 1, nxt); nA = has_next ? S.a_base(nxt) : cA; nB = has_next ? S.b_base(nxt) : cB; \
            if constexpr (GATHER) { if (has_next && wid < 4) __builtin_amdgcn_global_load_lds((const unsigned*)S.tok_addr(nxt, tid), (LAS unsigned*)(lds + TOK_OFF + wid * 256), 4, 0, 0); } } while (0)
#define PG8_NEXT_ROWS() do { if constexpr (GATHER) { if (has_next) { \
                _Pragma("unroll") for (int h = 0; h < 2; ++h) _Pragma("unroll") for (int i = 0; i < 2; ++i) { const int tk = *(const LAS int*)(lds + TOK_OFF + 4 * (128 * h + Rr[i])); vAn[h][i] = (unsigned)(tk * K + Cc[i]) * 2u; } } \
            else { _Pragma("unroll") for (int h = 0; h < 2; ++h) _Pragma("unroll") for (int i = 0; i < 2; ++i) vAn[h][i] = vA[h][i]; } } } while (0)
#define PG8_TRIP(t, MMX, HOOK) do { \
            const bool last = ((t) == nt - 2); bool seg16 = false; if constexpr (Sched::MIXED) seg16 = (t) >= S.nt8; (void)seg16; \
            const char* a1 = cA + (size_t)((t) + 1) * kstep; \
            const char* a2 = last ? nA : cA + (size_t)((t) + 2) * kstep; const char* b2 = last ? nB : cB + (size_t)((t) + 2) * kstep; \
            const char* a3 = a2 + kstep; const char* b3 = b2 + kstep; \
              \
            PG8_LB(B0, 0, 0); PG8_LB(B1, 0, 1); PG8_SCHED; PG8_LA(At, 0, 0); PG8_STA(PG8_SA(1, 1), a1, 1, false); \
            PG8_WAIT_V(8); PG8_WAIT_L(0); PG8_BAR; MMX(0, 0, At, B0); MMX(0, 1, At, B1); PG8_BAR; PG8_SCHED; HOOK; PG8_SCHED; \
              \
            PG8_LA(At, 0, 1); PG8_STAGE(PG8_SB(0, 0), b2, voffB); PG8_STAGE(PG8_SB(0, 1), b2 + hstep, voffB); PG8_STA(PG8_SA(0, 0), a2, 0, last); \
            PG8_WAIT_V(8); PG8_WAIT_L(0); PG8_BAR; MMX(1, 0, At, B0); MMX(1, 1, At, B1); PG8_BAR; PG8_SCHED; \
              \
            PG8_LB(B0, 1, 0); PG8_LB(B1, 1, 1); PG8_SCHED; PG8_LA(At, 1, 0); PG8_STA(PG8_SA(0, 1), a2, 1, last); \
            PG8_WAIT_V(8); PG8_WAIT_L(0); PG8_BAR; PG8_MM(0, 0, At, B0); PG8_MM(0, 1, At, B1); PG8_BAR; PG8_SCHED; \
              \
            PG8_LA(At, 1, 1); PG8_STAGE(PG8_SB(1, 0), b3, voffB); PG8_STAGE(PG8_SB(1, 1), b3 + hstep, voffB); PG8_STA(PG8_SA(1, 0), a3, 0, last); \
            PG8_WAIT_V(8); PG8_WAIT_L(0); PG8_BAR; PG8_MM(1, 0, At, B0); PG8_MM(1, 1, At, B1); PG8_BAR; PG8_SCHED; } while (0)
        PG8_TRIP(0, PG8_MM0, PG8_NEXT_UNIT());
        for (int t = 2; t < nt; t += 2) PG8_TRIP(t, PG8_MM, if (last) PG8_NEXT_ROWS());
#undef PG8_TRIP
#undef PG8_NEXT_UNIT
#undef PG8_NEXT_ROWS
        if (wr == 0) PG8_BAR;
        asm volatile("s_nop 15\n\ts_nop 15" ::: "memory");
        E(acc, cur, wr, wc, fr, fq);
        if (!has_next) break;
#pragma unroll
        for (int a = 0; a < 2; ++a)
#pragma unroll
            for (int b = 0; b < 2; ++b)
#pragma unroll
                for (int m = 0; m < 4; ++m)
#pragma unroll
                    for (int n = 0; n < 2; ++n) { asm volatile("" : "=v"(acc[a][b][m][n])); }
        cur = nxt; cA = nA; cB = nB; ++ui;
        if constexpr (GATHER) {
#pragma unroll
            for (int h = 0; h < 2; ++h)
#pragma unroll
                for (int i = 0; i < 2; ++i) vA[h][i] = vAn[h][i]; }
        if (wr == 1) PG8_BAR;
    }
    PG8_WAIT_V(0);
    PG8_BAR;
#undef PG8_SA
#undef PG8_SB
#undef PG8_STAGE
#undef PG8_STA
#undef PG8_LDA
#undef PG8_LDB
#undef PG8_MMA
#undef PG8_MMA8
#undef PG8_MMA8F
#undef PG8_MMAF
#undef PG8_MM0
#undef PG8_MM
#undef PG8_LD8
#undef PG8_LDA8
#undef PG8_LDB8
#undef PG8_LA
#undef PG8_LB
#undef PG8_WAIT_V
#undef PG8_WAIT_L
#undef PG8_BAR
#undef PG8_SCHED
}
}

__device__ __forceinline__ f32x4 silu_mul4(f32x4 g, f32x4 up) {
    const f32x2 g0 = {g[0], g[1]}, g1 = {g[2], g[3]}, u0 = {up[0], up[1]}, u1 = {up[2], up[3]};
    const f32x2 t0 = g0 * (-LOG2E), t1 = g1 * (-LOG2E);
    f32x2 e0, e1; e0.x = __builtin_amdgcn_exp2f(t0.x); e0.y = __builtin_amdgcn_exp2f(t0.y); e1.x = __builtin_amdgcn_exp2f(t1.x); e1.y = __builtin_amdgcn_exp2f(t1.y);
    const f32x2 d0 = e0 + 1.0f, d1 = e1 + 1.0f;
    f32x2 r0, r1; r0.x = __builtin_amdgcn_rcpf(d0.x); r0.y = __builtin_amdgcn_rcpf(d0.y); r1.x = __builtin_amdgcn_rcpf(d1.x); r1.y = __builtin_amdgcn_rcpf(d1.y);
    const f32x2 h0 = (g0 * u0) * r0, h1 = (g1 * u1) * r1;
    return (f32x4){h0.x, h0.y, h1.x, h1.y};
}
template <bool FP8ACC>
__device__ __forceinline__ f32x4 silu_mul4_scaled(f32x4 ag, f32x4 au) {
    constexpr float KT = FP8ACC ? -1.0f : -LOG2E, KD = FP8ACC ? LOG2E * W1_SCALE / H_SCALE : 1.0f / H_SCALE;
    const f32x2 g0 = {ag[0], ag[1]}, g1 = {ag[2], ag[3]}, u0 = {au[0], au[1]}, u1 = {au[2], au[3]};
    const f32x2 t0 = g0 * KT, t1 = g1 * KT;
    f32x2 e0, e1; e0.x = __builtin_amdgcn_exp2f(t0.x); e0.y = __builtin_amdgcn_exp2f(t0.y); e1.x = __builtin_amdgcn_exp2f(t1.x); e1.y = __builtin_amdgcn_exp2f(t1.y);
    const f32x2 d0 = e0 * KD + KD, d1 = e1 * KD + KD;
    f32x2 r0, r1; r0.x = __builtin_amdgcn_rcpf(d0.x); r0.y = __builtin_amdgcn_rcpf(d0.y); r1.x = __builtin_amdgcn_rcpf(d1.x); r1.y = __builtin_amdgcn_rcpf(d1.y);
    const f32x2 h0 = (g0 * u0) * r0, h1 = (g1 * u1) * r1;
    return (f32x4){h0.x, h0.y, h1.x, h1.y};
}
struct EpiSwiglu {
    bf16* out; int ldh;
    __device__ __forceinline__ void operator()(const f32x4 (&acc)[2][2][4][2], const pg8::Unit& u, int wr, int wc, int fr, int fq) const {
#pragma unroll
        for (int ai = 0; ai < 2; ++ai)
#pragma unroll
            for (int m = 0; m < 4; ++m) {
                const int row = u.pm * 256 + ai * 128 + wr * 64 + m * 16 + fr;
                u32x4 w;
#pragma unroll
                for (int bj = 0; bj < 2; ++bj) {
                    const f32x4 g = acc[ai][bj][m][0], up = acc[ai][bj][m][1]; f32x4 h;
                    h = silu_mul4(g, up);
                    if (bj == 0) { w.x = cvtpk(h[0], h[1]); w.y = cvtpk(h[2], h[3]); } else { w.z = cvtpk(h[0], h[1]); w.w = cvtpk(h[2], h[3]); }
                }
                *(GAS u32x4*)(out + (size_t)row * ldh + u.pn * 128 + wc * 32 + fq * 8) = w;
            }
    }
};
__device__ __forceinline__ unsigned pk4_fp8(float a, float b, float c, float d) { int p = __builtin_amdgcn_cvt_pk_fp8_f32(a, b, 0, false); p = __builtin_amdgcn_cvt_pk_fp8_f32(c, d, p, true); return (unsigned)p; }
__device__ __forceinline__ f32x4 fp8x4(unsigned w) { return (f32x4){__builtin_amdgcn_cvt_f32_fp8((int)w, 0), __builtin_amdgcn_cvt_f32_fp8((int)w, 1), __builtin_amdgcn_cvt_f32_fp8((int)w, 2), __builtin_amdgcn_cvt_f32_fp8((int)w, 3)}; }
template <bool SCALED>
struct EpiSwiglu8 {
    unsigned char* out; int ldh; int pn_off = 0;
    __device__ __forceinline__ void operator()(const f32x4 (&acc)[2][2][4][2], const pg8::Unit& u0, int wr, int wc, int fr, int fq) const {
        pg8::Unit u = u0; u.pn += pn_off;
#pragma unroll
        for (int ai = 0; ai < 2; ++ai)
#pragma unroll
            for (int m = 0; m < 4; ++m) {
                const int row = u.pm * 256 + ai * 128 + wr * 64 + m * 16 + fr;
                u32x2 w;
#pragma unroll
                for (int bj = 0; bj < 2; ++bj) {
                    f32x4 h;
                    h = silu_mul4_scaled<SCALED>(acc[ai][bj][m][0], acc[ai][bj][m][1]);
                    const unsigned p = pk4_fp8(h[0], h[1], h[2], h[3]);
                    if (bj == 0) w.x = p; else w.y = p;
                }
                *(GAS u32x2*)(out + (size_t)row * ldh + u.pn * 128 + wc * 32 + fq * 8) = w;
            }
    }
};
namespace pg8 { template <> struct gate_shift<EpiSwiglu8<true>> { static constexpr int value = 5; }; }
__device__ __forceinline__ f32x4 bf_lo4(u32x2 v) { return (f32x4){__uint_as_float(v.x << 16), __uint_as_float(v.x & 0xffff0000u), __uint_as_float(v.y << 16), __uint_as_float(v.y & 0xffff0000u)}; }
template <bool SC>
struct EpiResidT {
    bf16* xb; float sc;
    __device__ __forceinline__ void operator()(const f32x4 (&acc)[2][2][4][2], const pg8::Unit& u, int wr, int wc, int fr, int fq) const {
        bf16* p0 = xb + (size_t)(u.pm * 256 + wr * 64 + fr) * D + u.pn * 256 + wc * 32 + 8 * fq;
        u32x4 r[2][4][2];
#pragma unroll
        for (int ai = 0; ai < 2; ++ai)
#pragma unroll
            for (int m = 0; m < 4; ++m)
#pragma unroll
                for (int bj = 0; bj < 2; ++bj) r[ai][m][bj] = *(const GAS u32x4*)(p0 + (size_t)(ai * 128 + m * 16) * D + bj * 128);
#pragma unroll
        for (int ai = 0; ai < 2; ++ai)
#pragma unroll
            for (int m = 0; m < 4; ++m)
#pragma unroll
                for (int bj = 0; bj < 2; ++bj) {
                    const u32x4 rr = r[ai][m][bj];
                    const f32x4 r0 = bf_lo4((u32x2){rr.x, rr.y}), r1 = bf_lo4((u32x2){rr.z, rr.w});
                    f32x4 o0, o1;
                    if constexpr (SC) { o0 = r0 * ALPHA + acc[ai][bj][m][0] * sc; o1 = r1 * ALPHA + acc[ai][bj][m][1] * sc; } else { o0 = r0 * ALPHA + acc[ai][bj][m][0]; o1 = r1 * ALPHA + acc[ai][bj][m][1]; }
                    u32x4 w; w.x = cvtpk(o0[0], o0[1]); w.y = cvtpk(o0[2], o0[3]); w.z = cvtpk(o1[0], o1[1]); w.w = cvtpk(o1[2], o1[3]);
                    *(GAS u32x4*)(p0 + (size_t)(ai * 128 + m * 16) * D + bj * 128) = w;
                }
    }
};
typedef EpiResidT<false> EpiResid;
struct EpiY {
    bf16* out; int row_off; float sc; int ldc;
    __device__ __forceinline__ void operator()(const f32x4 (&acc)[2][2][4][2], const pg8::Unit& u, int wr, int wc, int fr, int fq) const {
#pragma unroll
        for (int ai = 0; ai < 2; ++ai)
#pragma unroll
            for (int m = 0; m < 4; ++m) {
                bf16* p = out + (size_t)(row_off + u.pm * 256 + ai * 128 + wr * 64 + m * 16 + fr) * ldc + u.pn * 256 + wc * 32 + 8 * fq;
#pragma unroll
                for (int bj = 0; bj < 2; ++bj) {
                    const f32x4 o0 = acc[ai][bj][m][0] * sc, o1 = acc[ai][bj][m][1] * sc;
                    u32x4 w; w.x = cvtpk(o0[0], o0[1]); w.y = cvtpk(o0[2], o0[3]); w.z = cvtpk(o1[0], o1[1]); w.w = cvtpk(o1[2], o1[3]);
                    *(GAS u32x4*)(p + bj * 128) = w;
                }
            }
    }
};

struct EpiYConv {
    bf16* out; unsigned char* out8; int pn_off;
    __device__ __forceinline__ void operator()(const f32x4 (&acc)[2][2][4][2], const pg8::Unit& u0, int wr, int wc, int fr, int fq) const {
        pg8::Unit u = u0; u.pn += pn_off;
        if (u.pn >= 9 && u.pn < 13) {
#pragma unroll
            for (int ai = 0; ai < 2; ++ai)
#pragma unroll
                for (int m = 0; m < 4; ++m) {
                    const int row = u.pm * 256 + ai * 128 + wr * 64 + m * 16 + fr;
                    const f32x4 z0 = acc[ai][0][m][0] * acc[ai][0][m][1], z1 = acc[ai][1][m][0] * acc[ai][1][m][1];
                    u32x4 w; w.x = cvtpk(z0[0], z0[1]); w.y = cvtpk(z0[2], z0[3]); w.z = cvtpk(z1[0], z1[1]); w.w = cvtpk(z1[2], z1[3]);
                    *(GAS u32x4*)(out + (size_t)row * ODD_IN + 2304 + (u.pn - 9) * 128 + wc * 32 + fq * 8) = w;
                }
        } else if (u.pn < 9) {
#pragma unroll
            for (int ai = 0; ai < 2; ++ai)
#pragma unroll
                for (int m = 0; m < 4; ++m) {
                    unsigned char* p = out8 + (size_t)(u.pm * 256 + ai * 128 + wr * 64 + m * 16 + fr) * 2304 + u.pn * 256 + wc * 32 + 8 * fq;
#pragma unroll
                    for (int bj = 0; bj < 2; ++bj) {
                        const f32x4 o0 = acc[ai][bj][m][0] * QKV_SCALE, o1 = acc[ai][bj][m][1] * QKV_SCALE;
                        u32x2 w; w.x = pk4_fp8(o0[0], o0[1], o0[2], o0[3]); w.y = pk4_fp8(o1[0], o1[1], o1[2], o1[3]);
                        *(GAS u32x2*)(p + bj * 128) = w;
                    }
                }
        } else {
            const int col0 = 2816 + (u.pn - 13) * 256 + wc * 32 + 8 * fq;
#pragma unroll
            for (int ai = 0; ai < 2; ++ai)
#pragma unroll
                for (int m = 0; m < 4; ++m) {
                    bf16* p = out + (size_t)(u.pm * 256 + ai * 128 + wr * 64 + m * 16 + fr) * ODD_IN + col0;
#pragma unroll
                    for (int bj = 0; bj < 2; ++bj) {
                        const f32x4 o0 = acc[ai][bj][m][0], o1 = acc[ai][bj][m][1];
                        u32x4 w; w.x = cvtpk(o0[0], o0[1]); w.y = cvtpk(o0[2], o0[3]); w.z = cvtpk(o1[0], o1[1]); w.w = cvtpk(o1[2], o1[3]);
                        *(GAS u32x4*)(p + bj * 128) = w;
                    }
                }
        }
    }
};
struct EpiQKV8 {
    unsigned char* out8; float sc;
    __device__ __forceinline__ void operator()(const f32x4 (&acc)[2][2][4][2], const pg8::Unit& u, int wr, int wc, int fr, int fq) const {
#pragma unroll
        for (int ai = 0; ai < 2; ++ai)
#pragma unroll
            for (int m = 0; m < 4; ++m) {
                unsigned char* p = out8 + (size_t)(u.pm * 256 + ai * 128 + wr * 64 + m * 16 + fr) * 2304 + u.pn * 256 + wc * 32 + 8 * fq;
#pragma unroll
                for (int bj = 0; bj < 2; ++bj) {
                    const f32x4 o0 = acc[ai][bj][m][0] * sc, o1 = acc[ai][bj][m][1] * sc;
                    u32x2 w; w.x = pk4_fp8(o0[0], o0[1], o0[2], o0[3]); w.y = pk4_fp8(o1[0], o1[1], o1[2], o1[3]);
                    *(GAS u32x2*)(p + bj * 128) = w;
                }
            }
    }
};
struct EpiY8 {
    unsigned char* out; float sc;
    __device__ __forceinline__ void operator()(const f32x4 (&acc)[2][2][4][2], const pg8::Unit& u, int wr, int wc, int fr, int fq) const {
#pragma unroll
        for (int ai = 0; ai < 2; ++ai)
#pragma unroll
            for (int m = 0; m < 4; ++m) {
                unsigned char* p = out + (size_t)(u.pm * 256 + ai * 128 + wr * 64 + m * 16 + fr) * D + u.pn * 256 + wc * 32 + 8 * fq;
#pragma unroll
                for (int bj = 0; bj < 2; ++bj) {
                    const f32x4 o0 = acc[ai][bj][m][0] * sc, o1 = acc[ai][bj][m][1] * sc;
                    u32x2 w; w.x = pk4_fp8(o0[0], o0[1], o0[2], o0[3]); w.y = pk4_fp8(o1[0], o1[1], o1[2], o1[3]);
                    *(GAS u32x2*)(p + bj * 128) = w;
                }
            }
    }
};

#define XB_TMO      128
#define XB_XCNT(j)  (256  + 64 * (j))
#define XB_XSUB(j)  (1280 + 64 * (j))
#define XB_XGEN(j)  (2304 + 64 * (j))
#define XB_TOP      3328
#define XB_TOPGEN   3392
#define XCD_BAR_WORDS 3456
#define XB_SPIN_CAP (1u << 18)
__device__ __forceinline__ unsigned xb_ld(unsigned* p)              { return __hip_atomic_load(p, __ATOMIC_RELAXED, __HIP_MEMORY_SCOPE_AGENT); }
__device__ __forceinline__ unsigned xb_add(unsigned* p, unsigned v) { return __hip_atomic_fetch_add(p, v, __ATOMIC_RELAXED, __HIP_MEMORY_SCOPE_AGENT); }
__device__ __forceinline__ unsigned xb_xcc_id() { return (unsigned)__builtin_amdgcn_s_getreg((3 << 11) | 20) & 0xFu; }
#define XB_SPIN(cond, bar) do { unsigned _sp = 0; while (cond) { __builtin_amdgcn_s_sleep(1); \
    if ((++_sp & 255u) == 0u) { if (xb_ld(&(bar)[XB_TMO])) break; if (_sp > XB_SPIN_CAP) { atomicAdd(&(bar)[XB_TMO], 1u); break; } } } } while (0)
struct XcdBarrier { unsigned* bar; unsigned x; volatile LAS unsigned* st; };
__device__ __forceinline__ XcdBarrier xcd_barrier_post(unsigned* bar, volatile LAS unsigned* st) {
    XcdBarrier b; b.bar = bar; b.x = xb_xcc_id(); b.st = st;
    if (threadIdx.x == 0) (void)xb_add(&bar[XB_XCNT(b.x)], 1u);
    return b;
}
__device__ __forceinline__ void xcd_barrier_complete(unsigned* bar, unsigned x, unsigned& nloc, unsigned& nx) {
    const unsigned G = gridDim.x * gridDim.y * gridDim.z;
    unsigned sum, cnt, mine, sp = 0u;
    for (;;) {
        sum = 0u; cnt = 0u; mine = 0u;
#pragma unroll
        for (unsigned j = 0; j < 16; ++j) { const unsigned c = xb_ld(&bar[XB_XCNT(j)]); sum += c; cnt += (c > 0u) ? 1u : 0u; mine = (j == x) ? c : mine; }
        if (sum == G) break;
        __builtin_amdgcn_s_sleep(1);
        if ((++sp & 255u) == 0u) { if (xb_ld(&bar[XB_TMO])) break; if (sp > XB_SPIN_CAP) { atomicAdd(&bar[XB_TMO], 1u); break; } }
    }
    nloc = mine > 0u ? mine : 1u; nx = cnt > 0u ? cnt : 1u;
}
__device__ __forceinline__ void xcd_barrier(const XcdBarrier& b) {
    asm volatile("s_waitcnt vmcnt(0)" ::: "memory");
    __syncthreads();
    if (threadIdx.x == 0) {
        unsigned* bar = b.bar;
        __builtin_amdgcn_s_waitcnt(0);
        unsigned nloc = b.st[0], nx = b.st[1];
        if (nloc == 0u) { xcd_barrier_complete(bar, b.x, nloc, nx); b.st[0] = nloc; b.st[1] = nx; }
        const unsigned old = xb_add(&bar[XB_XSUB(b.x)], 1u);
        const unsigned gen = old / nloc;
        if (old + 1u == (gen + 1u) * nloc) {
            __builtin_amdgcn_fence(__ATOMIC_RELEASE, "agent");
            asm volatile("s_waitcnt vmcnt(0)" ::: "memory");
            const unsigned og = xb_add(&bar[XB_TOP], 1u);
            const unsigned tg = og / nx;
            if (og + 1u == (tg + 1u) * nx) xb_add(&bar[XB_TOPGEN], 1u);
            else XB_SPIN(xb_ld(&bar[XB_TOPGEN]) == tg, bar);
            __builtin_amdgcn_fence(__ATOMIC_ACQUIRE, "agent");
            xb_add(&bar[XB_XGEN(b.x)], 1u);
            asm volatile("s_waitcnt vmcnt(0)" ::: "memory");
        } else {
            XB_SPIN(xb_ld(&bar[XB_XGEN(b.x)]) == gen, bar);
            __builtin_amdgcn_fence(__ATOMIC_ACQUIRE, "agent");
            asm volatile("s_waitcnt vmcnt(0)" ::: "memory");
        }
    }
    __syncthreads();
}

struct Frame {
    LAS unsigned char* lds;
    volatile LAS unsigned* MISC;
    gu32* ctl;
    int tid, lane, wave, vcu, G;
    const float* x; const int* pos; const float* ln_w; const float* ln_b;
    const float *even_w_in, *pool_w, *pool_scale, *sinks, *even_w_out, *ffn_wg, *ffn_wu, *ffn_wd, *odd_w_in, *conv_w, *odd_w_out, *router_w, *moe_wg, *moe_wu, *moe_wd;
    float* res;
    unsigned char* ws;
};

template <int MAP>
__device__ __forceinline__ void transpose_item(const float* W, int K, int N, bf16* WT, LAS float* scr, int item, int lane, int ldw = 0, int ldt = 0, float scale = 1.0f) {
    const int nblk = N / 32, kb = item / nblk, nb = item % nblk, k0 = 64 * kb, n0 = 32 * nb, ld = ldw ? ldw : N, lt = ldt ? ldt : K;
    float tv[32];
#pragma unroll
    for (int i = 0; i < 32; ++i) { const int kk = 2 * i + (lane >> 5); tv[i] = __builtin_nontemporal_load((const GAS float*)(W + (size_t)(k0 + kk) * ld + n0 + (lane & 31))); }
#pragma unroll
    for (int i = 0; i < 32; ++i) { const int kk = 2 * i + (lane >> 5); scr[kk * 33 + (lane & 31)] = tv[i] * scale; }
    LDS_WAIT(); asm volatile("" ::: "memory");
    const int c = lane & 7;
#pragma unroll
    for (int j = 0; j < 4; ++j) { const int n = (lane >> 3) + 8 * j; const LAS float* s = scr + (8 * c) * 33 + n;
        u32x4 o; o.x = pk2(s[0 * 33], s[1 * 33]); o.y = pk2(s[2 * 33], s[3 * 33]); o.z = pk2(s[4 * 33], s[5 * 33]); o.w = pk2(s[6 * 33], s[7 * 33]);
        *(GAS u32x4*)(WT + (size_t)dest_row<MAP>(n0 + n) * lt + k0 + 8 * c) = o; }
    LDS_WAIT(); asm volatile("" ::: "memory");
}

template <int MAP>
__device__ __forceinline__ void transpose_item8(const float* W, int K, int N, unsigned char* WT, LAS float* scr, int item, int lane, float scale, int ldw = 0, int ldt = 0) {
    const int nblk = N / 32, kb = item / nblk, nb = item % nblk, k0 = 64 * kb, n0 = 32 * nb, ld = ldw ? ldw : N, lt = ldt ? ldt : K;
    float tv[32];
#pragma unroll
    for (int i = 0; i < 32; ++i) { const int kk = 2 * i + (lane >> 5); tv[i] = __builtin_nontemporal_load((const GAS float*)(W + (size_t)(k0 + kk) * ld + n0 + (lane & 31))); }
#pragma unroll
    for (int i = 0; i < 32; ++i) { const int kk = 2 * i + (lane >> 5); scr[kk * 33 + (lane & 31)] = tv[i] * scale; }
    LDS_WAIT(); asm volatile("" ::: "memory");
    const int c = lane & 3;
#pragma unroll
    for (int j = 0; j < 2; ++j) { const int n = (lane >> 2) + 16 * j; const LAS float* s = scr + (16 * c) * 33 + n;
        u32x4 o; o.x = pk4_fp8(s[0 * 33], s[1 * 33], s[2 * 33], s[3 * 33]); o.y = pk4_fp8(s[4 * 33], s[5 * 33], s[6 * 33], s[7 * 33]);
        o.z = pk4_fp8(s[8 * 33], s[9 * 33], s[10 * 33], s[11 * 33]); o.w = pk4_fp8(s[12 * 33], s[13 * 33], s[14 * 33], s[15 * 33]);
        *(GAS u32x4*)(WT + (size_t)dest_row<MAP>(n0 + n) * lt + k0 + 16 * c) = o; }
    LDS_WAIT(); asm volatile("" ::: "memory");
}
__constant__ double ROPE_INV_FREQ[32] = {1.00000000000000000e+00, 7.49894209332455874e-01, 5.62341325190349073e-01, 4.21696503428582226e-01, 3.16227766016837941e-01, 2.37137370566165517e-01, 1.77827941003892293e-01, 1.33352143216332403e-01, 1.00000000000000006e-01, 7.49894209332455791e-02, 5.62341325190349114e-02, 4.21696503428582239e-02, 3.16227766016837913e-02, 2.37137370566165538e-02, 1.77827941003892293e-02, 1.33352143216332406e-02, 1.00000000000000002e-02, 7.49894209332455791e-03, 5.62341325190349097e-03, 4.21696503428582292e-03, 3.16227766016837939e-03, 2.37137370566165538e-03, 1.77827941003892275e-03, 1.33352143216332406e-03, 1.00000000000000002e-03, 7.49894209332455856e-04, 5.62341325190349097e-04, 4.21696503428582237e-04, 3.16227766016837939e-04, 2.37137370566165538e-04, 1.77827941003892270e-04, 1.33352143216332395e-04};
__device__ __forceinline__ void p0_prologue(Frame& F) {
    LAS float* scr = (LAS float*)(F.lds + F.wave * 16384);
    const int gw = F.vcu * NWAVES + F.wave, NGW = F.G * NWAVES;
    bf16* Wein = (bf16*)(F.ws + WS_WEIN); bf16* Weout = (bf16*)(F.ws + WS_WEOUT); bf16* Wgu = (bf16*)(F.ws + WS_WGU); bf16* Wdn = (bf16*)(F.ws + WS_WDN);
    bf16* Woin = (bf16*)(F.ws + WS_WOIN); bf16* Woout = (bf16*)(F.ws + WS_WOOUT);
    constexpr int I_EIN = 16 * (EVEN_IN / 32), I_SQ = 16 * 32, I_G = 16 * (DFF / 32), I_DN = (DFF / 64) * 32, I_OIN = 16 * (ODD_IN / 32);
    constexpr int NITEMS = I_EIN + I_SQ + 2 * I_G + I_DN + I_OIN + I_SQ;
    for (int it = gw; it < NITEMS; it += NGW) {
        int r = it;
        if (r < I_EIN) { transpose_item<4>(F.even_w_in, D, EVEN_IN, Wein, scr, r, F.lane); continue; } r -= I_EIN;
        if (r < I_SQ) { transpose_item<4>(F.even_w_out, D, D, Weout, scr, r, F.lane); continue; } r -= I_SQ;
        if (r < 2 * I_G) {
            const int up = r >= I_G, rr = r - up * I_G, tile = (32 * (rr % (DFF / 32))) >> 7; const float* W = up ? F.ffn_wu : F.ffn_wg;
            if (tile < NF8) { if (up) transpose_item8<3>(W, D, DFF, F.ws + WS_WGU8, scr, rr, F.lane, W1_SCALE); else transpose_item8<2>(W, D, DFF, F.ws + WS_WGU8, scr, rr, F.lane, W1_SCALE * LOG2E); }
            else { if (up) transpose_item<3>(W, D, DFF, Wgu, scr, rr, F.lane); else transpose_item<2>(W, D, DFF, Wgu, scr, rr, F.lane); }
            continue; }
        r -= 2 * I_G;
        if (r < I_DN) { transpose_item8<4>(F.ffn_wd, DFF, D, (unsigned char*)Wdn, scr, r, F.lane, W2_SCALE); continue; } r -= I_DN;
        if (r < I_OIN) {
            constexpr int I_A = 16 * (2304 / 32), I_C = 16 * (512 / 32);
            if (r < I_A) { transpose_item8<4>(F.odd_w_in, D, 2304, (unsigned char*)Woin, scr, r, F.lane, W1_SCALE, ODD_IN); continue; } r -= I_A;
            if (r < I_C) { transpose_item<2>(F.odd_w_in + 2304, D, 512, Woin + (size_t)2304 * D, scr, r, F.lane, ODD_IN); continue; } r -= I_C;
            if (r < I_C) { transpose_item<3>(F.odd_w_in + 3328, D, 512, Woin + (size_t)2304 * D, scr, r, F.lane, ODD_IN); continue; } r -= I_C;
            transpose_item<4>(F.odd_w_in + 2816, D, 512, Woin + (size_t)3328 * D, scr, r, F.lane, ODD_IN); continue; }
        r -= I_OIN;
        if (r < I_SQ / 2) transpose_item8<4>(F.odd_w_out, 512, D, (unsigned char*)Woout, scr, r, F.lane, W2_SCALE, 0, 1536);
        else transpose_item<4>(F.odd_w_out + (size_t)512 * D, 512, D, (bf16*)((unsigned char*)Woout + 512), scr, r - I_SQ / 2, F.lane, 0, 768, M_SCALE * W2_SCALE);
    }
    bf16* xb = (bf16*)(F.ws + WS_XB);
    {
        f32x4 na[4], nb[4];
#define X_LOAD(buf, mm) do { if ((mm) < T) { _Pragma("unroll") for (int j_ = 0; j_ < 4; ++j_) buf[j_] = __builtin_nontemporal_load((const GAS f32x4*)(F.x + (size_t)(mm) * D) + F.lane + 64 * j_); } } while (0)
#define X_ROW(buf, mm) do { f32x4 v[4]; _Pragma("unroll") for (int j = 0; j < 4; ++j) v[j] = buf[j]; \
            X_LOAD(buf, (mm) + 2 * NGW); \
            GAS u32x2* o = (GAS u32x2*)(xb + (size_t)(mm) * D) + F.lane; \
            _Pragma("unroll") for (int j = 0; j < 4; ++j) { u32x2 w; w.x = pk2(v[j].x, v[j].y); w.y = pk2(v[j].z, v[j].w); o[64 * j] = w; } } while (0)
        X_LOAD(na, gw); X_LOAD(nb, gw + NGW);
        for (int m = gw; m < T; m += 2 * NGW) {
            X_ROW(na, m);
            if (m + NGW < T) X_ROW(nb, m + NGW);
        }
#undef X_LOAD
#undef X_ROW
    }
    const int gt = F.vcu * (NWAVES * 64) + F.tid, NGT = F.G * NWAVES * 64;
    bf16* pwt = (bf16*)(F.ws + WS_POOLWT);
    for (int idx = gt; idx < 4 * 64 * 64; idx += NGT) { const int g = idx >> 12, dd = (idx >> 6) & 63, c = idx & 63; pwt[idx] = (bf16)f2bf(F.pool_w[(g * 64 + c) * 64 + dd]); }
}


__device__ __forceinline__ void ln_row(const bf16* zrow, const float* w, const float* b, bf16* ob, int lane, f32x4 (&y)[4]) {
    const GAS u32x2* xr = (const GAS u32x2*)zrow + lane;
    f32x4 v[4]; float s = 0.f;
#pragma unroll
    for (int j = 0; j < 4; ++j) { v[j] = bf_lo4(xr[64 * j]); s += (v[j].x + v[j].y) + (v[j].z + v[j].w); }
    const float mean = wave_sum(s) * (1.f / D); float s2 = 0.f;
#pragma unroll
    for (int j = 0; j < 4; ++j) { v[j] = v[j] - mean; s2 += (v[j].x * v[j].x + v[j].y * v[j].y) + (v[j].z * v[j].z + v[j].w * v[j].w); }
    const float rstd = 1.f / sqrtf(wave_sum(s2) * (1.f / D) + LN_EPS);
    GAS u32x2* o2 = (GAS u32x2*)ob + lane;
#pragma unroll
    for (int j = 0; j < 4; ++j) {
        const f32x4 ww = ((const GAS f32x4*)w)[lane + 64 * j], bb = ((const GAS f32x4*)b)[lane + 64 * j];
        y[j] = v[j] * rstd * ww + bb;
        if (ob) { u32x2 p; p.x = cvtpk(y[j].x, y[j].y); p.y = cvtpk(y[j].z, y[j].w); o2[64 * j] = p; }
    }
}
__device__ __forceinline__ void ln_phase(Frame& F, int lnidx, unsigned char* out8 = nullptr) {
    const int gw = F.vcu * NWAVES + F.wave, NGW = F.G * NWAVES, lane = F.lane;
    bf16* xb = (bf16*)(F.ws + WS_XB);
    f32x4 lw[4], lb[4];
#pragma unroll
    for (int j = 0; j < 4; ++j) { lw[j] = ((const GAS f32x4*)(F.ln_w + lnidx * D))[lane + 64 * j]; lb[j] = ((const GAS f32x4*)(F.ln_b + lnidx * D))[lane + 64 * j]; }
    u32x2 ra[4], rb[4];
#define LN_LOAD(buf, mm) do { if ((mm) < T) { _Pragma("unroll") for (int j_ = 0; j_ < 4; ++j_) buf[j_] = __builtin_nontemporal_load((const GAS u32x2*)(xb + (size_t)(mm) * D) + lane + 64 * j_); } } while (0)
#define LN_ROW(buf, mm) do { f32x4 v[4]; float s = 0.f; \
        _Pragma("unroll") for (int j = 0; j < 4; ++j) { v[j] = bf_lo4(buf[j]); s += (v[j].x + v[j].y) + (v[j].z + v[j].w); } \
        LN_LOAD(buf, (mm) + 2 * NGW); \
        const float mean = wave_sum(s) * (1.f / D); float s2 = 0.f; \
        _Pragma("unroll") for (int j = 0; j < 4; ++j) { v[j] = v[j] - mean; s2 += (v[j].x * v[j].x + v[j].y * v[j].y) + (v[j].z * v[j].z + v[j].w * v[j].w); } \
        const float rstd = 1.f / sqrtf(wave_sum(s2) * (1.f / D) + LN_EPS); \
        _Pragma("unroll") for (int j = 0; j < 4; ++j) { const f32x4 y = v[j] * rstd * lw[j] + lb[j]; u32x2 p; p.x = cvtpk(y.x, y.y); p.y = cvtpk(y.z, y.w); ((GAS u32x2*)(xb + (size_t)(mm) * D))[lane + 64 * j] = p; \
            if (out8) ((GAS unsigned*)(out8 + (size_t)(mm) * D))[lane + 64 * j] = pk4_fp8(y.x, y.y, y.z, y.w); } } while (0)
    LN_LOAD(ra, gw); LN_LOAD(rb, gw + NGW);
    for (int m = gw; m < T; m += 2 * NGW) {
        LN_ROW(ra, m);
        if (m + NGW < T) LN_ROW(rb, m + NGW);
    }
#undef LN_LOAD
#undef LN_ROW
}

constexpr int AT_KROW = 144;
constexpr int AT_VROW = 776;
constexpr int AT_K_OFF = 0, AT_V_OFF = 384 * AT_KROW;
static_assert(AT_V_OFF + 64 * AT_VROW <= RING_BYTES, "attention LDS");
__device__ __forceinline__ int crow(int reg, int h) { return (reg & 3) + 8 * (reg >> 2) + 4 * h; }
struct AttnUnit {
    const bf16* src; int ld;
    int rowbase, rstride, i0;
    int qcol0, nh, kcol, vcol;
    bf16* O; int ldo, ocol0;
    float qscale = C2, oscale = 1.0f;
    int o8 = 0;
    float* lse; int lse_h0;
    const float* sinks; int sink_h0;
    int maxdist;
    const int* pos;
};
__device__ __forceinline__ void rope_cs(float pf, float chi, float clo, float& c, float& sn) {
    const float rev = __builtin_amdgcn_fractf(pf * chi) + pf * clo;
    c = __builtin_amdgcn_cosf(rev); sn = __builtin_amdgcn_sinf(rev);
}
typedef _Float16 half2_t __attribute__((ext_vector_type(2)));
__device__ __forceinline__ float h_lo(unsigned w) { return (float)__builtin_bit_cast(half2_t, w).x; }
__device__ __forceinline__ float h_hi(unsigned w) { return (float)__builtin_bit_cast(half2_t, w).y; }
__device__ __forceinline__ void unpack8(u32x4 r, float (&f)[8]) {
#pragma unroll
    for (int q = 0; q < 4; ++q) { f[2 * q] = __uint_as_float(r[q] << 16); f[2 * q + 1] = __uint_as_float(r[q] & 0xffff0000u); } }
__device__ __forceinline__ void unpack8(u32x2 r, float (&f)[8]) { const f32x4 a = fp8x4(r.x), b = fp8x4(r.y); f[0] = a[0]; f[1] = a[1]; f[2] = a[2]; f[3] = a[3]; f[4] = b[0]; f[5] = b[1]; f[6] = b[2]; f[7] = b[3]; }
template <int IN8> struct Raw8 { typedef u32x4 T; };
template <> struct Raw8<1> { typedef u32x2 T; };
template <class RT>
__device__ __forceinline__ void rope_q(const RT (&qraw)[4], const float (&rc)[2][8], const float (&rs)[2][8], bf16x8 (&qf)[4]) {
#pragma unroll
    for (int a = 0; a < 2; ++a) {
        u32x4 w1, w2; float f1[8], f2[8]; unpack8(qraw[a], f1); unpack8(qraw[a + 2], f2);
#pragma unroll
        for (int q = 0; q < 4; ++q) {
            const float ca = rc[a][2 * q], cb = rc[a][2 * q + 1], sa = rs[a][2 * q], sb = rs[a][2 * q + 1];
            const float x1a = f1[2 * q], x1b = f1[2 * q + 1], x2a = f2[2 * q], x2b = f2[2 * q + 1];
            w1[q] = cvtpk(x1a * ca - x2a * sa, x1b * cb - x2b * sb); w2[q] = cvtpk(x2a * ca + x1a * sa, x2b * cb + x1b * sb);
        }
        qf[a] = __builtin_bit_cast(bf16x8, w1); qf[a + 2] = __builtin_bit_cast(bf16x8, w2);
    }
}
template <int V> struct IC { static constexpr int value = V; };
template <int NHH>
__device__ __forceinline__ void attn_heads(const AttnUnit& U, int hh0, const bf16x8 (*qf)[4], LAS unsigned char* ldsK, LAS unsigned char* ldsV,
                                           int qt, int iq, size_t qrow, int r32, int hi) {
    float m[NHH], l[NHH]; f32x16 o0[NHH], o1[NHH];
#pragma unroll
    for (int h = 0; h < NHH; ++h) {
        if (U.sinks) { m[h] = U.sinks[U.sink_h0 + hh0 + h] * LOG2E; l[h] = (hi == 0) ? 1.f : 0.f; } else { m[h] = -1e30f; l[h] = 0.f; }
#pragma unroll
        for (int i = 0; i < 16; ++i) { o0[h][i] = 0.f; o1[h][i] = 0.f; }
    }
    auto tile = [&](const int kt, auto mode_) {
        constexpr int MODE = decltype(mode_)::value;
        const int ktl = qt + kt, j0 = U.i0 - 128 + 32 * ktl;
        if (j0 < 0) return;
        bf16x8 kf[4];
#pragma unroll
        for (int d0 = 0; d0 < 4; ++d0) kf[d0] = *(const LAS bf16x8*)(ldsK + (32 * ktl + r32) * AT_KROW + d0 * 32 + hi * 16);
        f32x16 s[NHH];
#pragma unroll
        for (int h = 0; h < NHH; ++h) {
#pragma unroll
            for (int i = 0; i < 16; ++i) s[h][i] = 0.f;
        }
#pragma unroll
        for (int d0 = 0; d0 < 4; ++d0)
#pragma unroll
            for (int h = 0; h < NHH; ++h) s[h] = __builtin_amdgcn_mfma_f32_32x32x16_bf16(kf[d0], qf[h][d0], s[h], 0, 0, 0);
        if constexpr (MODE != 0) {
            const int dq = iq - j0 - 4 * hi, bb = (kt == 0) ? dq - U.maxdist : -dq, sg = (kt == 0) ? 1 : -1;
#pragma unroll
            for (int i = 0; i < 16; ++i) { const int ci = ((i & 3) + 8 * (i >> 2)) * sg; const bool ok = bb <= ci;
#pragma unroll
                for (int h = 0; h < NHH; ++h) s[h][i] = ok ? s[h][i] : -INFINITY; }
        }
        u32x4 pw[NHH][2];
#pragma unroll
        for (int h = 0; h < NHH; ++h) {
            float mt = s[h][0];
#pragma unroll
            for (int i = 1; i < 16; ++i) mt = fmaxf(mt, s[h][i]);
            { const auto rr = __builtin_amdgcn_permlane32_swap(__float_as_uint(mt), __float_as_uint(mt), false, false); mt = fmaxf(__uint_as_float(rr[0]), __uint_as_float(rr[1])); }
            if (__any(mt > m[h] + 8.0f)) {
                const float mn = fmaxf(m[h], mt), alpha = __builtin_amdgcn_exp2f(m[h] - mn); m[h] = mn; l[h] *= alpha;
#pragma unroll
                for (int i = 0; i < 16; ++i) { o0[h][i] *= alpha; o1[h][i] *= alpha; }
            }
            float ps = 0.f;
#pragma unroll
            for (int i = 0; i < 16; ++i) { s[h][i] = __builtin_amdgcn_exp2f(s[h][i] - m[h]); ps += s[h][i]; }
            l[h] += ps;
#pragma unroll
            for (int s2 = 0; s2 < 2; ++s2) { pw[h][s2].x = cvtpk(s[h][8 * s2 + 0], s[h][8 * s2 + 1]); pw[h][s2].y = cvtpk(s[h][8 * s2 + 2], s[h][8 * s2 + 3]); pw[h][s2].z = cvtpk(s[h][8 * s2 + 4], s[h][8 * s2 + 5]); pw[h][s2].w = cvtpk(s[h][8 * s2 + 6], s[h][8 * s2 + 7]); }
        }
#pragma unroll
        for (int s2 = 0; s2 < 2; ++s2) {
            const int kb = (32 * ktl + 16 * s2 + 4 * hi) * 2;
            { const u32x2 lo = *(const LAS u32x2*)(ldsV + r32 * AT_VROW + kb), hi8 = *(const LAS u32x2*)(ldsV + r32 * AT_VROW + kb + 16);
              u32x4 vv; vv.x = lo.x; vv.y = lo.y; vv.z = hi8.x; vv.w = hi8.y;
#pragma unroll
              for (int h = 0; h < NHH; ++h) o0[h] = __builtin_amdgcn_mfma_f32_32x32x16_bf16(__builtin_bit_cast(bf16x8, vv), __builtin_bit_cast(bf16x8, pw[h][s2]), o0[h], 0, 0, 0); }
            { const u32x2 lo = *(const LAS u32x2*)(ldsV + (32 + r32) * AT_VROW + kb), hi8 = *(const LAS u32x2*)(ldsV + (32 + r32) * AT_VROW + kb + 16);
              u32x4 vv; vv.x = lo.x; vv.y = lo.y; vv.z = hi8.x; vv.w = hi8.y;
#pragma unroll
              for (int h = 0; h < NHH; ++h) o1[h] = __builtin_amdgcn_mfma_f32_32x32x16_bf16(__builtin_bit_cast(bf16x8, vv), __builtin_bit_cast(bf16x8, pw[h][s2]), o1[h], 0, 0, 0); }
        }
    };
#pragma unroll 1
    for (int kt = 1; kt < 4; ++kt) tile(kt, IC<0>{});
#pragma unroll 1
    for (int kt = 0; kt < 5; kt += 4) tile(kt, IC<1>{});
#pragma unroll
    for (int h = 0; h < NHH; ++h) {
        float lt = l[h];
        { const auto rr = __builtin_amdgcn_permlane32_swap(__float_as_uint(lt), __float_as_uint(lt), false, false); lt = __uint_as_float(rr[0]) + __uint_as_float(rr[1]); }
        const float inv = __builtin_amdgcn_rcpf(lt) * U.oscale;
        if (U.o8) {
            const float i8 = inv * OG_SCALE; unsigned char* op8 = (unsigned char*)U.O + qrow * U.ldo + U.ocol0 + 64 * (hh0 + h);
#pragma unroll
            for (int g4 = 0; g4 < 4; ++g4) {
                *(GAS unsigned*)(op8 + 8 * g4 + 4 * hi) = pk4_fp8(o0[h][4 * g4] * i8, o0[h][4 * g4 + 1] * i8, o0[h][4 * g4 + 2] * i8, o0[h][4 * g4 + 3] * i8);
                *(GAS unsigned*)(op8 + 32 + 8 * g4 + 4 * hi) = pk4_fp8(o1[h][4 * g4] * i8, o1[h][4 * g4 + 1] * i8, o1[h][4 * g4 + 2] * i8, o1[h][4 * g4 + 3] * i8);
            }
        } else {
        bf16* op = U.O + qrow * U.ldo + U.ocol0 + 64 * (hh0 + h);
#pragma unroll
        for (int g4 = 0; g4 < 4; ++g4) {
            u32x2 w; w.x = cvtpk(o0[h][4 * g4] * inv, o0[h][4 * g4 + 1] * inv); w.y = cvtpk(o0[h][4 * g4 + 2] * inv, o0[h][4 * g4 + 3] * inv); *(GAS u32x2*)(op + 8 * g4 + 4 * hi) = w;
            u32x2 w2; w2.x = cvtpk(o1[h][4 * g4] * inv, o1[h][4 * g4 + 1] * inv); w2.y = cvtpk(o1[h][4 * g4 + 2] * inv, o1[h][4 * g4 + 3] * inv); *(GAS u32x2*)(op + 32 + 8 * g4 + 4 * hi) = w2;
        }
        }
        if (U.lse && hi == 0) U.lse[qrow * 8 + U.lse_h0 + hh0 + h] = m[h] + __builtin_amdgcn_logf(lt);
    }
}
template <int NH, int IN8> __device__ __forceinline__ void attn_unit(Frame& F, const AttnUnit& U) {
    typedef typename Raw8<IN8>::T RT; typedef typename std::conditional<IN8 != 0, unsigned char, bf16>::type ET;
    const ET* src = (const ET*)U.src;
    LAS unsigned char* ldsK = F.lds + AT_K_OFF; LAS unsigned char* ldsV = F.lds + AT_V_OFF;
    int tid = F.tid; asm volatile("" : "+v"(tid));
    const int lane = tid & 63, r32 = lane & 31, hi = lane >> 5, wid = F.wave;
    RT kv1[3], kv2[3], vv0[3], vv1[3]; int kp[3];
#pragma unroll
    for (int it = 0; it < 3; ++it) {
        const int idx = tid + it * (NWAVES * 64), kk = idx >> 2, ch = idx & 3, j = U.i0 - 128 + kk, jc = j < 0 ? 0 : j;
        const size_t tok = (size_t)(U.rowbase + jc * U.rstride);
        kv1[it] = *(const GAS RT*)(src + tok * U.ld + U.kcol + ch * 8); kv2[it] = *(const GAS RT*)(src + tok * U.ld + U.kcol + 32 + ch * 8);
        kp[it] = U.pos[tok];
    }
#pragma unroll
    for (int it = 0; it < 3; ++it) {
        const int idx = tid + it * (NWAVES * 64), p = idx % 192, ch = idx / 192, j = U.i0 - 128 + 2 * p, jc = j < 0 ? 0 : j;
        vv0[it] = *(const GAS RT*)(src + (size_t)(U.rowbase + jc * U.rstride) * U.ld + U.vcol + ch * 8);
        vv1[it] = *(const GAS RT*)(src + (size_t)(U.rowbase + (jc + 1) * U.rstride) * U.ld + U.vcol + ch * 8);
    }
    const int qt = wid;
    const int iq = U.i0 + 32 * qt + r32;
    const size_t qrow = (size_t)(U.rowbase + iq * U.rstride);
    RT qraw[NH][4]; const int qpos = U.pos[qrow];
#pragma unroll
    for (int h = 0; h < NH; ++h)
#pragma unroll
        for (int d0 = 0; d0 < 4; ++d0) qraw[h][d0] = *(const GAS RT*)(src + qrow * U.ld + U.qcol0 + 64 * h + 16 * d0 + 8 * hi);
    const LAS float* rcst = (const LAS float*)(F.lds + ROPEC_OFF);
    f32x4 khi[2], klo[2];
#pragma unroll
    for (int h2 = 0; h2 < 2; ++h2) { khi[h2] = *(const LAS f32x4*)(rcst + 8 * (tid & 3) + 4 * h2); klo[h2] = *(const LAS f32x4*)(rcst + 32 + 8 * (tid & 3) + 4 * h2); }
#pragma unroll
    for (int it = 0; it < 3; ++it) {
        const int idx = tid + it * (NWAVES * 64), kk = idx >> 2, ch = idx & 3;
        const float pf = (float)kp[it]; float f1[8], f2[8]; unpack8(kv1[it], f1); unpack8(kv2[it], f2);
        u32x4 w1, w2;
#pragma unroll
        for (int q = 0; q < 4; ++q) {
            float ca, cb, sa, sb; rope_cs(pf, khi[q >> 1][2 * (q & 1)], klo[q >> 1][2 * (q & 1)], ca, sa); rope_cs(pf, khi[q >> 1][2 * (q & 1) + 1], klo[q >> 1][2 * (q & 1) + 1], cb, sb);
            const float x1a = f1[2 * q], x1b = f1[2 * q + 1], x2a = f2[2 * q], x2b = f2[2 * q + 1];
            w1[q] = cvtpk(x1a * ca - x2a * sa, x1b * cb - x2b * sb); w2[q] = cvtpk(x2a * ca + x1a * sa, x2b * cb + x1b * sb);
        }
        *(LAS u32x4*)(ldsK + kk * AT_KROW + ch * 16) = w1; *(LAS u32x4*)(ldsK + kk * AT_KROW + 64 + ch * 16) = w2;
    }
#pragma unroll
    for (int it = 0; it < 3; ++it) {
        const int idx = tid + it * (NWAVES * 64), p = idx % 192, ch = idx / 192, kk = 2 * p;
        if constexpr (IN8) {
            float g0[8], g1[8]; unpack8(vv0[it], g0); unpack8(vv1[it], g1);
#pragma unroll
            for (int d = 0; d < 8; ++d) *(LAS unsigned*)(ldsV + (ch * 8 + d) * AT_VROW + kk * 2) = cvtpk(g0[d], g1[d]);
        } else {
#pragma unroll
        for (int q = 0; q < 4; ++q) {
            const unsigned a = vv0[it][q], b2 = vv1[it][q];
            *(LAS unsigned*)(ldsV + (ch * 8 + 2 * q) * AT_VROW + kk * 2) = (a & 0xffffu) | (b2 << 16);
            *(LAS unsigned*)(ldsV + (ch * 8 + 2 * q + 1) * AT_VROW + kk * 2) = (a >> 16) | (b2 & 0xffff0000u);
        }
        }
    }
    __syncthreads();
    bf16x8 qf[NH][4];
    {
        float rc[2][8], rs[2][8]; const float qpf = (float)qpos;
#pragma unroll
        for (int a = 0; a < 2; ++a)
#pragma unroll
            for (int j = 0; j < 8; ++j) { float c, sn; rope_cs(qpf, rcst[16 * a + 8 * hi + j], rcst[32 + 16 * a + 8 * hi + j], c, sn); rc[a][j] = c * U.qscale; rs[a][j] = sn * U.qscale; }
#pragma unroll
        for (int h = 0; h < NH; ++h) rope_q(qraw[h], rc, rs, qf[h]);
    }
    if (wid >= 4) __builtin_amdgcn_s_setprio(1);
    attn_heads<2>(U, 0, &qf[0], ldsK, ldsV, qt, iq, qrow, r32, hi);
    attn_heads<NH - 2>(U, 2, &qf[2], ldsK, ldsV, qt, iq, qrow, r32, hi);
    if (wid >= 4) __builtin_amdgcn_s_setprio(0);
    __syncthreads();
}

constexpr int PL_ROW = 528;
__device__ __forceinline__ void pool_unit(Frame& F, int unit) {
    const int b = unit >> 5, t0 = (unit & 31) * 128;
    const bf16* h0 = (const bf16*)(F.ws + WS_H0); bf16* m0 = (bf16*)(F.ws + WS_M0); const bf16* pwt = (const bf16*)(F.ws + WS_POOLWT);
    const int tid = F.tid, lane = F.lane, r32 = lane & 31, hi = lane >> 5, wid = F.wave;
    {
        constexpr int NIT = (143 * 32 + NWAVES * 64 - 1) / (NWAVES * 64);
        u32x4 pv[NIT];
#pragma unroll
        for (int it = 0; it < NIT; ++it) {
            const int idx = tid + it * (NWAVES * 64), lr = idx >> 5, ch = idx & 31, s = t0 - 15 + lr;
            pv[it] = (u32x4){0u, 0u, 0u, 0u};
            if (idx < 143 * 32 && s >= 0) pv[it] = *(const GAS u32x4*)(h0 + (size_t)(b * SEQ + s) * EVEN_IN + ch * 8);
        }
#pragma unroll
        for (int it = 0; it < NIT; ++it) {
            const int idx = tid + it * (NWAVES * 64), lr = idx >> 5, ch = idx & 31;
            if (idx < 143 * 32) *(LAS u32x4*)(F.lds + lr * PL_ROW + ch * 16) = pv[it];
        }
    }
    __syncthreads();
    const int tt = wid & 3, gp = wid >> 2;
    const int lr = 15 + 32 * tt + r32, spos = t0 + 32 * tt + r32;
    const size_t orow = (size_t)(b * SEQ + spos);
    auto group = [&](auto gi_) {
        constexpr int gi = decltype(gi_)::value, wd = 2 << gi;
        const float rc = 1.0f / (float)((spos + 1) < wd ? (spos + 1) : wd);
        bf16x8 df[4];
#pragma unroll
        for (int ks = 0; ks < 4; ++ks) {
            const int cb = (64 * gi + 16 * ks + 8 * hi) * 2;
            u32x4 rv[wd];
#pragma unroll
            for (int k = 0; k < wd; ++k) rv[k] = *(const LAS u32x4*)(F.lds + (lr - k) * PL_ROW + cb);
            float sum[8];
#pragma unroll
            for (int e = 0; e < 8; ++e) sum[e] = 0.f;
#pragma unroll
            for (int k = 0; k < wd; ++k)
#pragma unroll
                for (int q = 0; q < 4; ++q) { sum[2 * q] += __uint_as_float(rv[k][q] << 16); sum[2 * q + 1] += __uint_as_float(rv[k][q] & 0xffff0000u); }
            const u32x4 v = rv[0];
            u32x4 pw;
#pragma unroll
            for (int q = 0; q < 4; ++q) { const float d0 = sum[2 * q] * rc - __uint_as_float(v[q] << 16), d1 = sum[2 * q + 1] * rc - __uint_as_float(v[q] & 0xffff0000u); pw[q] = cvtpk(d0, d1); }
            df[ks] = __builtin_bit_cast(bf16x8, pw);
        }
#pragma unroll
        for (int nt = 0; nt < 2; ++nt) {
            f32x16 acc;
#pragma unroll
            for (int i = 0; i < 16; ++i) acc[i] = 0.f;
#pragma unroll
            for (int ks = 0; ks < 4; ++ks) { const bf16x8 wf = *(const GAS bf16x8*)(pwt + (size_t)(gi * 64 + 32 * nt + r32) * 64 + 16 * ks + 8 * hi); acc = __builtin_amdgcn_mfma_f32_32x32x16_bf16(wf, df[ks], acc, 0, 0, 0); }
#pragma unroll
            for (int g4 = 0; g4 < 4; ++g4) {
                const int dd = 64 * gi + 32 * nt + 8 * g4 + 4 * hi;
                const f32x4 sc = *(const GAS f32x4*)(F.pool_scale + dd);
                u32x2 w; w.x = cvtpk(acc[4 * g4] * sc[0], acc[4 * g4 + 1] * sc[1]); w.y = cvtpk(acc[4 * g4 + 2] * sc[2], acc[4 * g4 + 3] * sc[3]);
                *(GAS u32x2*)(m0 + orow * D + dd) = w;
            }
        }
    };
    if (gp == 0) { group(IC<0>{}); group(IC<3>{}); } else { group(IC<1>{}); group(IC<2>{}); }
    __syncthreads();
}

__device__ __forceinline__ void merge_phase(Frame& F) {
    const int gw = F.vcu * NWAVES + F.wave, NGW = F.G * NWAVES, lane = F.lane;
    const unsigned char* og = F.ws + WS_OG; const float* lse = (const float*)(F.ws + WS_LSE); unsigned char* m1 = F.ws + WS_M1;
    const int head = lane >> 3;
#pragma unroll 1
    for (int t0 = 8 * gw; t0 < T; t0 += 8 * NGW) {
        float l[8][3]; u32x2 a[8][3];
#pragma unroll
        for (int j = 0; j < 8; ++j)
#pragma unroll
            for (int g = 0; g < 3; ++g) { l[j][g] = __builtin_nontemporal_load((const GAS float*)(lse + ((size_t)g * T + (t0 + j)) * 8 + head)); a[j][g] = __builtin_nontemporal_load((const GAS u32x2*)(og + ((size_t)g * T + (t0 + j)) * 512 + 8 * lane)); }
#pragma unroll
        for (int j = 0; j < 8; ++j) {
            const float mx = fmaxf(l[j][0], fmaxf(l[j][1], l[j][2]));
            float w0 = __builtin_amdgcn_exp2f(l[j][0] - mx), w1 = __builtin_amdgcn_exp2f(l[j][1] - mx), w2 = __builtin_amdgcn_exp2f(l[j][2] - mx);
            const float ws_ = (M_SCALE / OG_SCALE) / (w0 + w1 + w2); w0 *= ws_; w1 *= ws_; w2 *= ws_;
            float mo[8];
#pragma unroll
            for (int q = 0; q < 2; ++q) { const f32x4 v_ = fp8x4(a[j][0][q]) * w0 + fp8x4(a[j][1][q]) * w1 + fp8x4(a[j][2][q]) * w2; mo[4 * q] = v_[0]; mo[4 * q + 1] = v_[1]; mo[4 * q + 2] = v_[2]; mo[4 * q + 3] = v_[3]; }
            u32x2 co; co.x = pk4_fp8(mo[0], mo[1], mo[2], mo[3]); co.y = pk4_fp8(mo[4], mo[5], mo[6], mo[7]);
            *(GAS u32x2*)(m1 + (size_t)(t0 + j) * 1536 + 8 * lane) = co;
        }
    }
}

__device__ __forceinline__ void conv_chunk(Frame& F, int chunk) {
    const int lane = F.lane, t0 = chunk * 128 + F.wave * 16;
    const bf16* h1 = (const bf16*)(F.ws + WS_H1) + 2304 + 8 * lane; unsigned char* m1 = F.ws + WS_M1 + 512 + 16 * lane;
    float cw[3][8];
#pragma unroll
    for (int k = 0; k < 3; ++k)
#pragma unroll
        for (int e = 0; e < 8; ++e) cw[k][e] = F.conv_w[k * 512 + 8 * lane + e];
    float z1[8], z2[8];
#pragma unroll
    for (int e = 0; e < 8; ++e) { z1[e] = 0.f; z2[e] = 0.f; }
    if ((t0 & (SEQ - 1)) != 0) {
        const u32x4 h_1 = *(const GAS u32x4*)(h1 + (size_t)(t0 - 1) * ODD_IN), h_2 = *(const GAS u32x4*)(h1 + (size_t)(t0 - 2) * ODD_IN);
#pragma unroll
        for (int q = 0; q < 4; ++q) {
            z1[2 * q] = __uint_as_float(h_1[q] << 16); z1[2 * q + 1] = __uint_as_float(h_1[q] & 0xffff0000u);
            z2[2 * q] = __uint_as_float(h_2[q] << 16); z2[2 * q + 1] = __uint_as_float(h_2[q] & 0xffff0000u);
        }
    }
    u32x4 hn[2], bn[2];
#define CV_LOAD(s_, tk) do { const bf16* r_ = h1 + (size_t)(tk) * ODD_IN; hn[s_] = *(const GAS u32x4*)r_; bn[s_] = *(const GAS u32x4*)(r_ + 512); } while (0)
    CV_LOAD(0, t0); CV_LOAD(1, t0 + 1);
#pragma unroll
    for (int i = 0; i < 16; ++i) {
        const u32x4 hd = hn[i & 1], gb = bn[i & 1];
        if (i + 2 < 16) CV_LOAD(i & 1, t0 + i + 2);
        float z0[8], y[8];
#pragma unroll
        for (int q = 0; q < 4; ++q) { z0[2 * q] = __uint_as_float(hd[q] << 16); z0[2 * q + 1] = __uint_as_float(hd[q] & 0xffff0000u); }
#pragma unroll
        for (int e = 0; e < 8; ++e) { y[e] = cw[0][e] * z2[e] + cw[1][e] * z1[e] + cw[2][e] * z0[e]; z2[e] = z1[e]; z1[e] = z0[e]; }
#pragma unroll
        for (int q = 0; q < 4; ++q) { y[2 * q] *= __uint_as_float(gb[q] << 16); y[2 * q + 1] *= __uint_as_float(gb[q] & 0xffff0000u); }
        u32x4 dv; dv.x = cvtpk(y[0], y[1]); dv.y = cvtpk(y[2], y[3]); dv.z = cvtpk(y[4], y[5]); dv.w = cvtpk(y[6], y[7]);
        *(GAS u32x4*)(m1 + (size_t)(t0 + i) * 1536) = dv;
    }
#undef CV_LOAD
}

constexpr int MC_IG = 16 * (DFFE / 32), MC_ID = (DFFE / 64) * 32, MC_GU = NE * 2 * MC_IG, MC_ITEMS = MC_GU + NE * MC_ID;
__device__ __forceinline__ void moe_convert_items(Frame& F, const int it0, const int step, const int end) {
    const int lane = F.lane;
    LAS float* scr = (LAS float*)(F.lds + F.wave * 16384);
    const float* cwg = F.moe_wg; const float* cwu = F.moe_wu; const float* cwd = F.moe_wd; asm volatile("" : "+s"(cwg), "+s"(cwu), "+s"(cwd));
#define CONV_DESC(it_, W_, WT_, K_, N_, k0_, n0_, map_, sc_) do { int r_ = (it_); \
        if (r_ < MC_GU) { const int e_ = r_ / (2 * MC_IG); r_ %= 2 * MC_IG; const int up_ = r_ >= MC_IG; r_ -= up_ * MC_IG; W_ = (up_ ? cwu : cwg) + (size_t)e_ * D * DFFE; K_ = D; N_ = DFFE; WT_ = (unsigned char*)F.res + DO_WM8 + (size_t)e_ * 2 * DFFE * D; map_ = 2 + up_; sc_ = up_ ? W1_SCALE : W1_SCALE * LOG2E; } \
        else { r_ -= MC_GU; const int e_ = r_ / MC_ID; r_ %= MC_ID; W_ = cwd + (size_t)e_ * DFFE * D; K_ = DFFE; N_ = D; WT_ = (unsigned char*)F.res + DO_WMD8 + (size_t)e_ * D * DFFE; map_ = 4; sc_ = W2_SCALE; } \
        const int nblk_ = N_ / 32; k0_ = 64 * (r_ / nblk_); n0_ = 32 * (r_ % nblk_); } while (0)
    {
        float tvn[32]; const float* nW; unsigned char* nWT; int nK, nN, nk0, nn0, nmap; float nsc;
        CONV_DESC((it0 < end ? it0 : 0), nW, nWT, nK, nN, nk0, nn0, nmap, nsc);
#pragma unroll
        for (int i = 0; i < 32; ++i) { const int kk = 2 * i + (lane >> 5); tvn[i] = __builtin_nontemporal_load((const GAS float*)(nW + (size_t)(nk0 + kk) * nN + nn0 + (lane & 31))); }
        for (int it = it0; it < end; it += step) {
            unsigned char* const cWT = nWT; const int cK = nK, ck0 = nk0, cn0 = nn0, cmap = nmap; const float csc = nsc; float tv[32];
#pragma unroll
            for (int i = 0; i < 32; ++i) tv[i] = tvn[i];
            if (it + step < end) { CONV_DESC(it + step, nW, nWT, nK, nN, nk0, nn0, nmap, nsc);
#pragma unroll
                for (int i = 0; i < 32; ++i) { const int kk = 2 * i + (lane >> 5); tvn[i] = __builtin_nontemporal_load((const GAS float*)(nW + (size_t)(nk0 + kk) * nN + nn0 + (lane & 31))); } }
#pragma unroll
            for (int i = 0; i < 32; ++i) { const int kk = 2 * i + (lane >> 5); scr[kk * 33 + (lane & 31)] = tv[i] * csc; }
            LDS_WAIT(); asm volatile("" ::: "memory");
            const int c = lane & 3;
#pragma unroll
            for (int j = 0; j < 2; ++j) { const int n = (lane >> 2) + 16 * j; const LAS float* sp = scr + (16 * c) * 33 + n;
                u32x4 o; o.x = pk4_fp8(sp[0 * 33], sp[1 * 33], sp[2 * 33], sp[3 * 33]); o.y = pk4_fp8(sp[4 * 33], sp[5 * 33], sp[6 * 33], sp[7 * 33]);
                o.z = pk4_fp8(sp[8 * 33], sp[9 * 33], sp[10 * 33], sp[11 * 33]); o.w = pk4_fp8(sp[12 * 33], sp[13 * 33], sp[14 * 33], sp[15 * 33]);
                const int nn = cn0 + n; const int dr = (cmap == 4) ? dest_row<4>(nn) : (cmap == 3 ? dest_row<3>(nn) : dest_row<2>(nn));
                *(GAS u32x4*)(cWT + (size_t)dr * cK + ck0 + 16 * c) = o; }
            LDS_WAIT(); asm volatile("" ::: "memory");
        }
    }
#undef CONV_DESC
}

constexpr int MC_DN_EARLY = 4096;
__device__ __forceinline__ void moe_down_convert_dynamic(Frame& F, const int done) {
    LAS int* slot = (LAS int*)(F.lds + TOK_OFF);
    constexpr int CH = 16; const int NCH = (NE * MC_ID - done) / CH;
    static_assert((NE * MC_ID) % CH == 0 && MC_DN_EARLY % CH == 0, "chunking");
    __syncthreads();
    if (F.tid == 0) slot[0] = (int)__hip_atomic_fetch_add(F.ctl + CW_DCV, 1u, RLX_AGENT);
    __syncthreads();
    int cur = __builtin_amdgcn_readfirstlane(slot[0]);
    while (cur < NCH) {
        __syncthreads();
        unsigned nxt = 0; if (F.tid == 0) nxt = __hip_atomic_fetch_add(F.ctl + CW_DCV, 1u, RLX_AGENT);
        moe_convert_items(F, MC_GU + done + cur * CH + F.wave, NWAVES, MC_GU + done + (cur + 1) * CH);
        if (F.tid == 0) slot[0] = (int)nxt;
        __syncthreads();
        cur = __builtin_amdgcn_readfirstlane(slot[0]);
    }
}

__device__ __forceinline__ void router_phase(Frame& F) {
    const int gw = F.vcu * NWAVES + F.wave, NGW = F.G * NWAVES, lane = F.lane, tid = F.tid;
    LAS float* rw = (LAS float*)F.lds;
    LAS int* rinfo = (LAS int*)(F.lds + 32768);
    LAS int* lcnt = (LAS int*)(F.lds + 32768 + 8 * 32 * 6 * 4);
    if (tid < 16) lcnt[tid] = 0;
    __syncthreads();
    f32x4 rwa[4][4], rwb[4][4];
#pragma unroll
    for (int j = 0; j < 4; ++j)
#pragma unroll
        for (int q = 0; q < 4; ++q) { const int c = 4 * lane + 256 * j + q; rwa[j][q] = *(const GAS f32x4*)(F.router_w + c * 8); rwb[j][q] = *(const GAS f32x4*)(F.router_w + c * 8 + 4); }
    (void)rw;
    unsigned char* x8 = (unsigned char*)F.res + DO_X8; bf16* xb = (bf16*)(F.ws + WS_XB);
    f32x4 lw[4], lb[4];
#pragma unroll
    for (int j = 0; j < 4; ++j) { lw[j] = ((const GAS f32x4*)(F.ln_w + 2 * D))[lane + 64 * j]; lb[j] = ((const GAS f32x4*)(F.ln_b + 2 * D))[lane + 64 * j]; }
    u32x2 rawa[4], rawb[4];
#define RT_LOAD(buf, mm) do { if ((mm) < T) { _Pragma("unroll") for (int j_ = 0; j_ < 4; ++j_) buf[j_] = __builtin_nontemporal_load((const GAS u32x2*)(xb + (size_t)(mm) * D) + lane + 64 * j_); } } while (0)
    RT_LOAD(rawa, gw); RT_LOAD(rawb, gw + NGW);
    auto do_row = [&](u32x2 (&rawn)[4], const int m, const int k) {
        f32x4 v[4], y[4]; float s = 0.f;
#pragma unroll
        for (int j = 0; j < 4; ++j) { v[j] = bf_lo4(rawn[j]); s += (v[j].x + v[j].y) + (v[j].z + v[j].w); }
        RT_LOAD(rawn, m + 2 * NGW);
        const float mean = wave_sum(s) * (1.f / D); float s2 = 0.f;
#pragma unroll
        for (int j = 0; j < 4; ++j) { v[j] = v[j] - mean; s2 += (v[j].x * v[j].x + v[j].y * v[j].y) + (v[j].z * v[j].z + v[j].w * v[j].w); }
        const float rstd = 1.f / sqrtf(wave_sum(s2) * (1.f / D) + LN_EPS);
#pragma unroll
        for (int j = 0; j < 4; ++j) {
            y[j] = v[j] * rstd * lw[j] + lb[j];
            ((GAS unsigned*)(x8 + (size_t)m * D))[lane + 64 * j] = pk4_fp8(y[j].x, y[j].y, y[j].z, y[j].w);
        }
        float lg[8];
#pragma unroll
        for (int e = 0; e < 8; ++e) lg[e] = 0.f;
#pragma unroll
        for (int j = 0; j < 4; ++j)
#pragma unroll
            for (int q = 0; q < 4; ++q) { const f32x4 wa = rwa[j][q], wb = rwb[j][q]; const float xv = y[j][q];
                lg[0] += xv * wa[0]; lg[1] += xv * wa[1]; lg[2] += xv * wa[2]; lg[3] += xv * wa[3]; lg[4] += xv * wb[0]; lg[5] += xv * wb[1]; lg[6] += xv * wb[2]; lg[7] += xv * wb[3]; }
        float r4[4], r2[2], r1;
#pragma unroll
        for (int i = 0; i < 4; ++i) { const float snd = (lane & 32) ? lg[i] : lg[i + 4], kp = (lane & 32) ? lg[i + 4] : lg[i]; r4[i] = kp + __shfl_xor(snd, 32); }
#pragma unroll
        for (int i = 0; i < 2; ++i) { const float snd = (lane & 16) ? r4[i] : r4[i + 2], kp = (lane & 16) ? r4[i + 2] : r4[i]; r2[i] = kp + __shfl_xor(snd, 16); }
        { const float snd = (lane & 8) ? r2[0] : r2[1], kp = (lane & 8) ? r2[1] : r2[0]; r1 = kp + __shfl_xor(snd, 8); }
        r1 += __shfl_xor(r1, 4); r1 += __shfl_xor(r1, 2); r1 += __shfl_xor(r1, 1);
        float lgt[8];
#pragma unroll
        for (int e = 0; e < 8; ++e) lgt[e] = __uint_as_float(__builtin_amdgcn_readlane(__float_as_uint(r1), 8 * e));
        {
            int e0 = 0; float b0 = lgt[0];
#pragma unroll
            for (int e = 1; e < 8; ++e) if (lgt[e] > b0) { b0 = lgt[e]; e0 = e; }
            int e1 = -1; float b1 = -INFINITY;
#pragma unroll
            for (int e = 0; e < 8; ++e) if (e != e0 && lgt[e] > b1) { b1 = lgt[e]; e1 = e; }
            const float g1 = 1.0f / (1.0f + __expf(b0 - b1)), g0 = 1.0f - g1;
            if (lane == 0) {
                const int ls0 = atomicAdd((int*)&lcnt[e0], 1), ls1 = atomicAdd((int*)&lcnt[e1], 1);
                LAS int* ri = rinfo + (F.wave * 32 + k) * 6;
                ri[0] = e0; ri[1] = e1; ri[2] = __float_as_int(g0); ri[3] = __float_as_int(g1); ri[4] = ls0; ri[5] = ls1;
            }
        }
    };
    for (int m = gw, k = 0; m < T; m += 2 * NGW, k += 2) {
        do_row(rawa, m, k);
        if (m + NGW < T) do_row(rawb, m + NGW, k + 1);
    }
#undef RT_LOAD
    __syncthreads();
    if (tid < 8) lcnt[8 + tid] = (int)__hip_atomic_fetch_add(F.ctl + CW_CNT + 64 * tid, (unsigned)lcnt[tid], RLX_AGENT);
    __syncthreads();
    int* list = (int*)(F.ws + WS_LIST); int* tinfo = (int*)(F.ws + WS_TOKINFO);
    for (int kk = lane; kk < 32; kk += 64) {
        const int m = gw + kk * NGW;
        if (m < T) {
            const LAS int* ri = rinfo + (F.wave * 32 + kk) * 6;
            const int e0 = ri[0], e1 = ri[1], s0 = lcnt[8 + e0] + ri[4], s1 = lcnt[8 + e1] + ri[5];
            list[(size_t)e0 * T + s0] = m; list[(size_t)e1 * T + s1] = m;
            int* ti = tinfo + (size_t)m * 6; ti[0] = e0; ti[1] = s0; ti[2] = ri[2]; ti[3] = e1; ti[4] = s1; ti[5] = ri[3];
        }
    }
    __syncthreads();
    if (F.G != 256) moe_convert_items(F, gw, NGW, MC_GU);
}

__device__ __forceinline__ void moe_tables(Frame& F) {
    LAS int* tab = (LAS int*)(F.lds + TAB_OFF);
    __syncthreads();
    if (F.tid < 64) {
        const int c = (F.lane < 8) ? (int)__hip_atomic_load(F.ctl + CW_CNT + 64 * F.lane, RLX_AGENT) : 0, nt = (c + 255) >> 8;
        int tp = 0;
#pragma unroll
        for (int e = 0; e < 8; ++e) { const int v = __builtin_amdgcn_readlane(nt, e); tp += (F.lane > e) ? v : 0; }
        if (F.lane < 8) { tab[F.lane] = c; tab[8 + F.lane] = tp; }
        if (F.lane == 8) tab[16] = tp < MAXTILES ? tp : MAXTILES;
    }
    __syncthreads();
    for (int t = F.tid; t < tab[16]; t += NWAVES * 64) {
        int e = 0;
#pragma unroll
        for (int k = 1; k < 8; ++k) e = (t >= tab[8 + k]) ? k : e;
        tab[32 + t] = e; tab[32 + MAXTILES + t] = tab[8 + e];
    }
    __syncthreads();
}
struct MoeSched1 {
    static constexpr bool VAR_NT = false, MIXED = false;
    pg8::StaticOrder so; int g0; const LAS int* tab; const char* X; const char* W; const int* list;
    __device__ __forceinline__ bool next(int i, pg8::Unit& u) const { return so.next(i, u); }
    __device__ __forceinline__ const char* a_base(const pg8::Unit&) const { return X; }
    __device__ __forceinline__ const char* b_base(const pg8::Unit& u) const { const int e = tab[32 + g0 + u.pm]; return W + (size_t)e * (2 * DFFE * D) + (size_t)u.pn * (256 * D); }
    __device__ __forceinline__ const int* tok_addr(const pg8::Unit& u, int row) const {
        const int G = g0 + u.pm, e = tab[32 + G], rt = G - tab[32 + MAXTILES + G], cnt = tab[e], slot = rt * 256 + row;
        return list + (size_t)e * T + (slot < cnt ? slot : 0);
    }
    __device__ __forceinline__ void a_rows_load(const pg8::Unit& u, const int (&R)[2], int (&tok)[2][2]) const {
        const int G = g0 + u.pm, e = tab[32 + G], rt = G - tab[32 + MAXTILES + G], cnt = tab[e];
#pragma unroll
        for (int h = 0; h < 2; ++h)
#pragma unroll
            for (int i = 0; i < 2; ++i) { const int slot = rt * 256 + 128 * h + R[i]; tok[h][i] = list[(size_t)e * T + (slot < cnt ? slot : 0)]; }
    }
    __device__ __forceinline__ void a_rows_off(const int (&tok)[2][2], int K, const int (&C)[2], unsigned (&off)[2][2]) const {
#pragma unroll
        for (int h = 0; h < 2; ++h)
#pragma unroll
            for (int i = 0; i < 2; ++i) off[h][i] = (unsigned)(tok[h][i] * K + C[i]) * 2u;
    }
    __device__ __forceinline__ void a_rows(const pg8::Unit& u, int K, const int (&R)[2], const int (&C)[2], unsigned (&off)[2][2]) const { int tok[2][2]; a_rows_load(u, R, tok); a_rows_off(tok, K, C, off); }
};
struct MoeSched2 {
    static constexpr bool VAR_NT = true, MIXED = false;
    pg8::StaticOrder so; int ntail; const LAS int* tab; const char* H; const char* W;
    __device__ __forceinline__ static void decode(const pg8::Unit& u, int ntail, int& tile, int& kq) { if (u.pm >= Y2_TILE0) { kq = 1 + (u.pm - Y2_TILE0) / 8; tile = (u.pm - Y2_TILE0) % 8; } else { kq = 0; tile = u.pm; } (void)ntail; }
    __device__ __forceinline__ bool next(int i, pg8::Unit& u) const {
        if (so.next(i, u)) { u.pm = ntail + so.nM - 1 - u.pm; return true; }
        if (ntail == 0) return false;
        const int c = (i - 4) * so.G + so.c;
        if (i < 4 || c >= 16 * ntail) return false;
        const int tile = c >> 4, kq = c & 3; u.pn = (c >> 2) & 3; u.pm = kq ? Y2_TILE0 + 8 * (kq - 1) + tile : tile; return true;
    }
    __device__ __forceinline__ int ktiles(const pg8::Unit& u) const { if (u.pm >= ntail && u.pm < Y2_TILE0) return DFFE / 128; int tile, kq; decode(u, ntail, tile, kq); return kq < 2 ? 8 : 6; }
    __device__ __forceinline__ int koff(const pg8::Unit& u) const { if (u.pm >= ntail && u.pm < Y2_TILE0) return 0; int tile, kq; decode(u, ntail, tile, kq); return (kq == 0 ? 0 : kq == 1 ? 8 : kq == 2 ? 16 : 22) * 128; }
    __device__ __forceinline__ int tile_of(const pg8::Unit& u) const { int tile, kq; decode(u, ntail, tile, kq); return tile; }
    __device__ __forceinline__ const char* a_base(const pg8::Unit& u) const { return H + (size_t)tile_of(u) * (256 * DFFE) + koff(u); }
    __device__ __forceinline__ const char* b_base(const pg8::Unit& u) const { const int e = tab[32 + tile_of(u)]; return W + (size_t)e * (D * DFFE) + (size_t)u.pn * (256 * DFFE) + koff(u); }
    __device__ __forceinline__ void a_rows(const pg8::Unit&, int, const int (&)[2], const int (&)[2], unsigned (&)[2][2]) const {}
};

__device__ __forceinline__ void final_phase(Frame& F) {
    const int gw = F.vcu * NWAVES + F.wave, NGW = F.G * NWAVES, lane = F.lane;
    const LAS int* tab = (const LAS int*)(F.lds + TAB_OFF);
    const int* tinfo = (const int*)(F.ws + WS_TOKINFO); const unsigned char* yb = F.ws + WS_Y; const bf16* xb = (const bf16*)(F.ws + WS_XB);
    f32x4 lw[4], lb[4], lw2[4], lb2[4];
#pragma unroll
    for (int j = 0; j < 4; ++j) { lw[j] = ((const GAS f32x4*)(F.ln_w + 3 * D))[lane + 64 * j]; lb[j] = ((const GAS f32x4*)(F.ln_b + 3 * D))[lane + 64 * j];
        lw2[j] = ((const GAS f32x4*)(F.ln_w + 2 * D))[lane + 64 * j] * ALPHA; lb2[j] = ((const GAS f32x4*)(F.ln_b + 2 * D))[lane + 64 * j] * ALPHA; }
    const int lrows = (F.G == 256 && tab[16] > 256 && tab[16] <= 264) ? (tab[16] - 256) * 256 : 0;
    const unsigned char* y2 = F.ws + WS_Y2;
    struct Rows { u32x2 x[4]; unsigned a[4], c[4]; float g0, g1; int l0, l1; };
    Rows RA, RB; u32x4 iv4 = {0u, 0u, 0u, 0u}; u32x2 iv2 = {0u, 0u};
#define FIN_LOAD_INFO(mm) do { if ((mm) < T) { const int* ti_ = tinfo + (size_t)(mm) * 6; iv4 = *(const GAS u32x4*)ti_; iv2 = *(const GAS u32x2*)(ti_ + 4); } } while (0)
#define FIN_LOAD_ROWS(R, mm) do { if ((mm) < T) { const int t0_ = __builtin_amdgcn_readfirstlane((int)iv4.x), t1_ = __builtin_amdgcn_readfirstlane((int)iv4.y), t2_ = __builtin_amdgcn_readfirstlane((int)iv4.z), \
            t3_ = __builtin_amdgcn_readfirstlane((int)iv4.w), t4_ = __builtin_amdgcn_readfirstlane((int)iv2.x), t5_ = __builtin_amdgcn_readfirstlane((int)iv2.y); \
        const int r0_ = tab[8 + t0_] * 256 + t1_, r1_ = tab[8 + t3_] * 256 + t4_; R.g0 = __int_as_float(t2_) * (1.0f / Y_SCALE); R.g1 = __int_as_float(t5_) * (1.0f / Y_SCALE); \
        R.l0 = __builtin_amdgcn_readfirstlane(r0_) < lrows ? __builtin_amdgcn_readfirstlane(r0_) : -1; R.l1 = __builtin_amdgcn_readfirstlane(r1_) < lrows ? __builtin_amdgcn_readfirstlane(r1_) : -1; \
        FIN_LOAD_INFO((mm) + NGW); \
        _Pragma("unroll") for (int j_ = 0; j_ < 4; ++j_) { R.x[j_] = __builtin_nontemporal_load((const GAS u32x2*)(xb + (size_t)(mm) * D) + lane + 64 * j_); R.a[j_] = __builtin_nontemporal_load((const GAS unsigned*)(yb + (size_t)r0_ * D) + lane + 64 * j_); \
            R.c[j_] = __builtin_nontemporal_load((const GAS unsigned*)(yb + (size_t)r1_ * D) + lane + 64 * j_); } } } while (0)
#define FIN_ROW(R, m) do { f32x4 v[4]; float s = 0.f; const float g0 = R.g0, g1 = R.g1; const int l0 = R.l0, l1 = R.l1; unsigned ya[4], yc[4]; \
        _Pragma("unroll") for (int j = 0; j < 4; ++j) { v[j] = bf_lo4(R.x[j]); ya[j] = R.a[j]; yc[j] = R.c[j]; s += (v[j].x + v[j].y) + (v[j].z + v[j].w); } \
        FIN_LOAD_ROWS(R, (m) + 2 * NGW); \
        const float mean3 = wave_sum(s) * (1.f / D); float q3 = 0.f; s = 0.f; \
        _Pragma("unroll") for (int j = 0; j < 4; ++j) { v[j] = v[j] - mean3; q3 += (v[j].x * v[j].x + v[j].y * v[j].y) + (v[j].z * v[j].z + v[j].w * v[j].w); } \
        const float rstd3 = 1.f / sqrtf(wave_sum(q3) * (1.f / D) + LN_EPS); \
        _Pragma("unroll") for (int j = 0; j < 4; ++j) v[j] = (v[j] * rstd3 * lw2[j] + lb2[j]) + (fp8x4(ya[j]) * g0 + fp8x4(yc[j]) * g1); \
        if (l0 >= 0) { _Pragma("unroll") for (int pl = 0; pl < 3; ++pl) _Pragma("unroll") for (int j = 0; j < 4; ++j) v[j] = v[j] + fp8x4(*((const GAS unsigned*)(y2 + ((size_t)pl * 2048 + l0) * D) + lane + 64 * j)) * g0; } \
        if (l1 >= 0) { _Pragma("unroll") for (int pl = 0; pl < 3; ++pl) _Pragma("unroll") for (int j = 0; j < 4; ++j) v[j] = v[j] + fp8x4(*((const GAS unsigned*)(y2 + ((size_t)pl * 2048 + l1) * D) + lane + 64 * j)) * g1; } \
        _Pragma("unroll") for (int j = 0; j < 4; ++j) s += (v[j].x + v[j].y) + (v[j].z + v[j].w); \
        const float mean = wave_sum(s) * (1.f / D); float s2 = 0.f; \
        _Pragma("unroll") for (int j = 0; j < 4; ++j) { v[j] = v[j] - mean; s2 += (v[j].x * v[j].x + v[j].y * v[j].y) + (v[j].z * v[j].z + v[j].w * v[j].w); } \
        const float rstd = 1.f / sqrtf(wave_sum(s2) * (1.f / D) + LN_EPS); \
        GAS f32x4* xr = (GAS f32x4*)(F.res + (size_t)(m) * D) + lane; \
        _Pragma("unroll") for (int j = 0; j < 4; ++j) __builtin_nontemporal_store(v[j] * rstd * lw[j] + lb[j], xr + 64 * j); } while (0)
    FIN_LOAD_INFO(gw); FIN_LOAD_ROWS(RA, gw); FIN_LOAD_ROWS(RB, gw + NGW);
    for (int m = gw; m < T; m += 2 * NGW) {
        FIN_ROW(RA, m);
        if (m + NGW < T) FIN_ROW(RB, m + NGW);
    }
#undef FIN_ROW
#undef FIN_LOAD_INFO
#undef FIN_LOAD_ROWS
}

constexpr int N_PHASES = 16;
struct Args { const void* in[19]; float* out; unsigned char* ws; int ph_lo, ph_hi; };
__global__ void __launch_bounds__(NWAVES * 64, 2) skel_fwd(Args args) {
    extern __shared__ __attribute__((aligned(16))) unsigned char lds[];
    Frame F;
    F.lds = (LAS unsigned char*)lds;
    F.MISC = (volatile LAS unsigned*)(F.lds + MISC_OFF);
    F.tid = threadIdx.x; F.lane = F.tid & 63; F.wave = __builtin_amdgcn_readfirstlane(F.tid >> 6);
    F.G = gridDim.x; { const int bx = blockIdx.x; F.vcu = (F.G % 8 == 0) ? (bx % 8) * (F.G / 8) + bx / 8 : bx; }
    F.ws = args.ws; F.ctl = (gu32*)(args.ws + WS_CTL); F.res = args.out;
    F.x = (const float*)args.in[0]; F.pos = (const int*)args.in[1]; F.ln_w = (const float*)args.in[2]; F.ln_b = (const float*)args.in[3];
    F.even_w_in = (const float*)args.in[4]; F.pool_w = (const float*)args.in[5]; F.pool_scale = (const float*)args.in[6]; F.sinks = (const float*)args.in[7];
    F.even_w_out = (const float*)args.in[8]; F.ffn_wg = (const float*)args.in[9]; F.ffn_wu = (const float*)args.in[10]; F.ffn_wd = (const float*)args.in[11];
    F.odd_w_in = (const float*)args.in[12]; F.conv_w = (const float*)args.in[13]; F.odd_w_out = (const float*)args.in[14]; F.router_w = (const float*)args.in[15];
    F.moe_wg = (const float*)args.in[16]; F.moe_wu = (const float*)args.in[17]; F.moe_wd = (const float*)args.in[18];
    for (int u = F.tid; u < (LDS_BYTES - LDSCTL_OFF) / 4; u += NWAVES * 64) ((LAS unsigned*)(F.lds + LDSCTL_OFF))[u] = 0u;
    __syncthreads();
    if (F.tid < 32) {
        const double c = ROPE_INV_FREQ[F.tid] * 0.15915494309189533577;
        const float chi = __uint_as_float(__float_as_uint((float)c) & 0xffffe000u), clo = (float)(c - (double)chi);
        ((LAS float*)(F.lds + ROPEC_OFF))[F.tid] = chi; ((LAS float*)(F.lds + ROPEC_OFF))[32 + F.tid] = clo;
    }
    __syncthreads();
    XcdBarrier bar; bar.bar = (unsigned*)(F.ctl + CW_BAR); bar.x = 0; bar.st = nullptr;
    if (!MK_PER_PHASE) bar = xcd_barrier_post((unsigned*)(F.ctl + CW_BAR), F.MISC + 8);
    const int lo = args.ph_lo, hi = args.ph_hi;
#define IN(k) (lo <= (k) && (k) < hi)
#define SEAM(k) do { if (IN(k) && IN((k) + 1)) xcd_barrier(bar); } while (0)
    const int bid = (int)blockIdx.x;
    bf16* XB = (bf16*)(F.ws + WS_XB);

    if (IN(0)) { p0_prologue(F); SEAM(0); }
    if (IN(1)) {
        pg8::PlainSched S; S.so.init(T / 256, EVEN_IN / 256, F.G, bid); S.A = (const char*)XB; S.B = (const char*)(F.ws + WS_WEIN); S.tstep = (size_t)256 * D * 2;
        EpiY E{(bf16*)(F.ws + WS_H0), 0, 1.0f, EVEN_IN};
        pg8::gemm_phase<false, false>(F.lds, D, S, E); SEAM(1);
    }
    if (IN(2)) {
        {
        for (int u = F.vcu; u < 512; u += F.G) {
            const int b = u >> 6, kvh = (u >> 4) & 3, blk = u & 15;
            AttnUnit U; U.src = (const bf16*)(F.ws + WS_H0); U.ld = EVEN_IN; U.rowbase = b * SEQ; U.rstride = 1; U.i0 = 256 * blk;
            U.qcol0 = 256 + 64 * 3 * kvh; U.nh = 3; U.kcol = 1024 + 64 * kvh; U.vcol = 1280 + 64 * kvh;
            U.O = (bf16*)(F.ws + WS_M0); U.ldo = D; U.ocol0 = 256 + 64 * 3 * kvh; U.lse = nullptr; U.lse_h0 = 0; U.sinks = F.sinks; U.sink_h0 = 3 * kvh; U.maxdist = 127; U.pos = F.pos;
            attn_unit<3, 0>(F, U);
        }
        for (int u = F.vcu; u < 256; u += F.G) pool_unit(F, u);
        }
        SEAM(2);
    }
    if (IN(3)) {
        pg8::PlainSched S; S.so.init(T / 256, D / 256, F.G, bid); S.A = (const char*)(F.ws + WS_M0); S.B = (const char*)(F.ws + WS_WEOUT); S.tstep = (size_t)256 * D * 2;
        EpiResid E{XB, 1.0f};
        pg8::gemm_phase<false, false>(F.lds, D, S, E); SEAM(3);
    }
    if (IN(4)) { ln_phase(F, 0, (unsigned char*)F.res + DO_X2_8); SEAM(4); }
    if (IN(5)) {
        {
            pg8::PlainSched S8; S8.so.init(T / 256, NF8, F.G, bid); S8.A = (const char*)F.res + DO_X2_8; S8.B = (const char*)(F.ws + WS_WGU8); S8.tstep = (size_t)256 * D;
            EpiSwiglu8<true> E8{F.ws + WS_HF, DFF};
            pg8::gemm_phase<false, true>(F.lds, D / 2, S8, E8);
        }
        pg8::PlainSched S; S.so.init(T / 256, 2 * DFF / 256 - NF8, F.G, bid); S.A = (const char*)XB; S.B = (const char*)(F.ws + WS_WGU) + (size_t)NF8 * 256 * D * 2; S.tstep = (size_t)256 * D * 2;
        EpiSwiglu8<false> E{F.ws + WS_HF, DFF, NF8};
        pg8::gemm_phase<false, false>(F.lds, D, S, E);
        SEAM(5);
    }
    if (IN(6)) {
        pg8::PlainSched S; S.so.init(T / 256, D / 256, F.G, bid); S.A = (const char*)(F.ws + WS_HF); S.B = (const char*)(F.ws + WS_WDN); S.tstep = (size_t)256 * DFF; S.rev = 1;
        EpiResidT<true> E{XB, 1.0f / (H_SCALE * W2_SCALE)};
        pg8::gemm_phase<false, true>(F.lds, DFF / 2, S, E); SEAM(6);
    }
    if (IN(7)) { ln_phase(F, 1, (unsigned char*)F.res + DO_X2_8); SEAM(7); }
    if (IN(8)) {
        pg8::PlainSched S; S.so.init(T / 256, ODD_IN / 256, F.G, bid); S.A = (const char*)XB; S.B = (const char*)(F.ws + WS_WOIN); S.tstep = (size_t)256 * D * 2;
        {
            pg8::PlainSched S8; S8.so.init(T / 256, 2304 / 256, F.G, bid); S8.A = (const char*)F.res + DO_X2_8; S8.B = (const char*)(F.ws + WS_WOIN); S8.tstep = (size_t)256 * D;
            EpiQKV8 E8{(unsigned char*)F.res + DO_H1A8, QKV_SCALE / W1_SCALE};
            pg8::gemm_phase<false, true>(F.lds, D / 2, S8, E8);
        }
        S.so.init(T / 256, (ODD_IN - 2304) / 256, F.G, bid); S.B = (const char*)(F.ws + WS_WOIN) + (size_t)2304 * D * 2;
        EpiYConv E{(bf16*)(F.ws + WS_H1), (unsigned char*)F.res + DO_H1A8, 9};
        pg8::gemm_phase<false, false>(F.lds, D, S, E); SEAM(8);
    }
    if (IN(9)) {
        if (bid & 1) for (int c = F.vcu; c < T / 128; c += F.G) conv_chunk(F, c);
        for (int u = F.vcu; u < 768; u += F.G) {
            const int g = u >> 8, v = u & 255, b = v >> 5, w = v & 31, kvh = w >> 4, xx = w & 15;
            const int dil = (g == 0) ? 1 : (g == 1) ? 4 : 16; const int r = xx % dil, blk = xx / dil;
            AttnUnit U; U.src = (const bf16*)(F.ws + WS_H1); U.ld = ODD_IN; U.rowbase = b * SEQ + r; U.rstride = dil; U.i0 = 256 * blk;
            U.qcol0 = 768 * g + 64 * 4 * kvh; U.nh = 4; U.kcol = 768 * g + 512 + 64 * kvh; U.vcol = 768 * g + 640 + 64 * kvh;
            U.O = (bf16*)(F.ws + WS_OG + (size_t)g * T * 512); U.ldo = 512; U.ocol0 = 64 * 4 * kvh; U.o8 = 1;
            U.lse = (float*)(F.ws + WS_LSE) + (size_t)g * T * 8; U.lse_h0 = 4 * kvh; U.sinks = nullptr; U.sink_h0 = 0; U.maxdist = 128; U.pos = F.pos;
            U.src = (const bf16*)((const unsigned char*)F.res + DO_H1A8); U.ld = 2304; U.qscale = C2 / (QKV_SCALE * QKV_SCALE); U.oscale = 1.0f / QKV_SCALE;
            attn_unit<4, 1>(F, U);
        }
        if (!(bid & 1)) for (int c = F.vcu; c < T / 128; c += F.G) conv_chunk(F, c);
        SEAM(9);
    }
    if (IN(10)) { merge_phase(F); SEAM(10); }
    if (IN(11)) {
        const bool split = (F.G == 256); const int half_id = (bid >> 4) * 8 + (bid & 7);
        if (split && ((bid >> 3) & 1)) { moe_convert_items(F, half_id * NWAVES + F.wave, 128 * NWAVES, MC_GU); moe_convert_items(F, MC_GU + half_id * NWAVES + F.wave, 128 * NWAVES, MC_GU + MC_DN_EARLY); }
        else {
        pg8::MixSched S; S.so.init(T / 256, D / 256, split ? 128 : F.G, split ? half_id : bid); S.A = (const char*)(F.ws + WS_M1); S.B = (const char*)(F.ws + WS_WOOUT); S.tstep = (size_t)256 * 1536; S.nt8 = 4;
        EpiResidT<true> E{XB, 1.0f / (M_SCALE * W2_SCALE)};
        pg8::gemm_phase<false, true>(F.lds, 768, S, E);
        }
        SEAM(11);
    }
    if (IN(12)) { router_phase(F); SEAM(12); }
    if (IN(13)) {
        moe_tables(F);
        const LAS int* tab = (const LAS int*)(F.lds + TAB_OFF);
        MoeSched1 S; S.so.init(tab[16], 2 * DFFE / 256, F.G, bid); S.g0 = 0; S.tab = tab; S.X = (const char*)F.res + DO_X8; S.W = (const char*)F.res + DO_WM8; S.list = (const int*)(F.ws + WS_LIST);
        EpiSwiglu8<true> E{F.ws + WS_HC8, DFFE};
        pg8::gemm_phase<true, true>(F.lds, D / 2, S, E);
        moe_down_convert_dynamic(F, F.G == 256 ? MC_DN_EARLY : 0); SEAM(13);
    }
    if (IN(14)) {
        if (!IN(13)) moe_tables(F);
        const LAS int* tab = (const LAS int*)(F.lds + TAB_OFF);
        const int ntail = (F.G == 256 && tab[16] > 256 && tab[16] <= 264) ? tab[16] - 256 : 0;
        MoeSched2 S; S.so.init(tab[16] - ntail, D / 256, F.G, bid); S.ntail = ntail; S.tab = tab; S.H = (const char*)(F.ws + WS_HC8); S.W = (const char*)F.res + DO_WMD8;
        EpiY8 E{F.ws + WS_Y, Y_SCALE / (H_SCALE * W2_SCALE)};
        pg8::gemm_phase<false, true>(F.lds, DFFE / 2, S, E);
        SEAM(14);
    }
    if (IN(N_PHASES - 1)) { if (!IN(13)) moe_tables(F); final_phase(F); }
#undef IN
#undef SEAM
}

extern "C" void kernel_launch(void* const* d_in, const int* in_sizes, int n_in, void* d_out, int out_size, void* d_ws, size_t ws_size, hipStream_t stream) {
    static int grid = 0;
    if (grid == 0) {
        if (n_in != 19 || out_size != T * D || ws_size < WS_END) { fprintf(stderr, "kernel_launch: unexpected sizes (n_in %d out %d ws %zu, need %zu)\n", n_in, out_size, ws_size, (size_t)WS_END); grid = -1; return; }
        int dev = 0, cus = 0, per_cu = 0;
        if (hipGetDevice(&dev) != hipSuccess || hipDeviceGetAttribute(&cus, hipDeviceAttributeMultiprocessorCount, dev) != hipSuccess) { grid = -1; return; }
        if (hipFuncSetAttribute((const void*)skel_fwd, hipFuncAttributeMaxDynamicSharedMemorySize, LDS_BYTES) != hipSuccess) { fprintf(stderr, "kernel_launch: hipFuncSetAttribute failed\n"); grid = -1; return; }
        if (hipOccupancyMaxActiveBlocksPerMultiprocessor(&per_cu, (const void*)skel_fwd, NWAVES * 64, LDS_BYTES) != hipSuccess || per_cu < 1) fprintf(stderr, "kernel_launch: occupancy query reports %d\n", per_cu);
        (void)hipGetLastError();
        grid = cus;
    }
    if (grid < 0) return;
    (void)in_sizes;
    if (hipMemsetAsync((char*)d_ws + WS_CTL, 0, CTL_ZERO_BYTES, stream) != hipSuccess) return;
    Args a{};
    for (int i = 0; i < 19; ++i) a.in[i] = d_in[i];
    a.out = (float*)d_out; a.ws = (unsigned char*)d_ws;
#if MK_PER_PHASE
    for (int p = 0; p < N_PHASES; ++p) { a.ph_lo = p; a.ph_hi = p + 1; hipLaunchKernelGGL(skel_fwd, dim3(grid), dim3(NWAVES * 64), LDS_BYTES, stream, a); }
#else
    a.ph_lo = 0; a.ph_hi = N_PHASES;
    hipLaunchKernelGGL(skel_fwd, dim3(grid), dim3(NWAVES * 64), LDS_BYTES, stream, a);
#endif
}
```
